# Optimizing an MI355X kernel written in HIP

```python
import math
import jax, jax.numpy as jnp
from jax import lax
import numpy as np

D_MODEL = 1024
BATCH = 2
SEQ = 8192
DEPTH = 1
DEC_BATCH = 128
DEC_SEQ = 1
PAST_LEN = 8192
PAGE_SIZE = 128

SSM_WIDTH = D_MODEL
SSM_GROUP = 16
SSM_GROUPS = SSM_WIDTH // SSM_GROUP
SSM_STATE = 64
SSM_CHUNK = 128
N_HEADS = 16
HEAD_DIM = D_MODEL // N_HEADS
N_KV_HEADS = 4
KV_GROUP = N_HEADS // N_KV_HEADS
ATTN_WIDTH = N_HEADS * HEAD_DIM
KV_WIDTH = N_KV_HEADS * HEAD_DIM
WINDOW = 128
ATTN_BLOCK = WINDOW
N_BUCKETS = 32
MAX_DISTANCE = WINDOW
NEG_INF = -1e30
LN_EPS = 1e-5
DEEPNORM_ALPHA = (2 * DEPTH) ** 0.25
DEEPNORM_BETA = (8 * DEPTH) ** -0.25
SPLITS = (SSM_WIDTH, SSM_WIDTH, ATTN_WIDTH, KV_WIDTH, KV_WIDTH, ATTN_WIDTH, D_MODEL, D_MODEL)
D_IN = SSM_WIDTH * 2 + ATTN_WIDTH * 2 + KV_WIDTH * 2 + D_MODEL * 2

kernel_name = "hybrid_s5_swa_gated_decoder_step"


def layer_norm(x, g, b):
    xf = x.astype(jnp.float32)
    mu = xf.mean(-1, keepdims=True)
    var = jnp.square(xf - mu).mean(-1, keepdims=True)
    return ((xf - mu) * lax.rsqrt(var + LN_EPS) * g.astype(jnp.float32) + b.astype(jnp.float32)).astype(x.dtype)


def rel_bucket(dist):
    max_exact = N_BUCKETS // 2
    df = jnp.maximum(dist, 1).astype(jnp.float32)
    large = max_exact + (jnp.log(df / max_exact) / math.log(MAX_DISTANCE / max_exact)
                         * (N_BUCKETS - max_exact)).astype(jnp.int32)
    large = jnp.minimum(large, N_BUCKETS - 1)
    return jnp.where(dist < max_exact, dist, large)


def rel_bias_from_dist(dist, rel_bias):
    b = rel_bias.astype(jnp.float32)[rel_bucket(jnp.clip(dist, 0, WINDOW))]
    return jnp.transpose(b, (2, 0, 1)).reshape(N_KV_HEADS, KV_GROUP, *dist.shape)


def sink_softmax(s, sinks):
    sk = sinks.astype(jnp.float32).reshape(N_KV_HEADS, KV_GROUP, 1)
    m = jnp.maximum(s.max(-1), sk)
    e = jnp.exp(s - m[..., None])
    return e / (e.sum(-1, keepdims=True) + jnp.exp(sk - m)[..., None])


def swa_prompt(q, k, v, sinks, rel_bias):
    b, l = q.shape[:2]
    nb = l // ATTN_BLOCK
    qb = q.reshape(b, nb, ATTN_BLOCK, N_KV_HEADS, KV_GROUP, HEAD_DIM)

    def band(t):
        tb = t.reshape(b, nb, ATTN_BLOCK, N_KV_HEADS, HEAD_DIM)
        prev = jnp.concatenate([jnp.zeros_like(tb[:, :1]), tb[:, :-1]], axis=1)
        return jnp.concatenate([prev, tb], axis=2)

    kk, vv = band(k), band(v)
    s = jnp.einsum('bnqkgd,bnskd->bnkgqs', qb, kk, preferred_element_type=jnp.float32) * (HEAD_DIM ** -0.5)
    qi = jnp.arange(ATTN_BLOCK)[:, None]
    kj = jnp.arange(2 * ATTN_BLOCK)[None, :]
    dist = qi + ATTN_BLOCK - kj
    key_pos = jnp.arange(nb)[:, None, None] * ATTN_BLOCK + kj[None] - ATTN_BLOCK
    mask = ((dist >= 0) & (dist <= WINDOW))[None] & (key_pos >= 0)
    s = s + rel_bias_from_dist(dist, rel_bias)
    s = jnp.where(mask[None, :, None, None], s, NEG_INF)
    p = sink_softmax(s, sinks)
    o = jnp.einsum('bnkgqs,bnskd->bnqkgd', p.astype(vv.dtype), vv)
    return o.reshape(b, l, ATTN_WIDTH)


def swa_sample(q, k, v, k_buf, v_buf, sinks, rel_bias):
    b, t = q.shape[:2]
    qg = q.reshape(b, t, N_KV_HEADS, KV_GROUP, HEAD_DIM)
    kk = jnp.concatenate([k_buf.astype(k.dtype), k], axis=1)
    vv = jnp.concatenate([v_buf.astype(v.dtype), v], axis=1)
    s = jnp.einsum('btkgd,bskd->bkgts', qg, kk, preferred_element_type=jnp.float32) * (HEAD_DIM ** -0.5)
    dist = jnp.arange(t)[:, None] + WINDOW - jnp.arange(WINDOW + t)[None, :]
    mask = (dist >= 0) & (dist <= WINDOW)
    s = s + rel_bias_from_dist(dist, rel_bias)
    s = jnp.where(mask, s, NEG_INF)
    p = sink_softmax(s, sinks)
    o = jnp.einsum('bkgts,bskd->btkgd', p.astype(vv.dtype), vv)
    return o.reshape(b, t, ATTN_WIDTH), kk[:, -WINDOW:], vv[:, -WINDOW:]


def ssm_discretise(lam_re, lam_im, log_delta, b_re, b_im):
    lr = lam_re.astype(jnp.float32)
    li = lam_im.astype(jnp.float32)
    dt = jnp.exp(log_delta.astype(jnp.float32))[:, None]
    mag = jnp.exp(lr * dt)
    ar, ai = mag * jnp.cos(li * dt), mag * jnp.sin(li * dt)
    den = lr * lr + li * li
    nr = ar - 1.0
    cr = (nr * lr + ai * li) / den
    ci = (ai * lr - nr * li) / den
    br, bi = b_re.astype(jnp.float32), b_im.astype(jnp.float32)
    bbr = cr[..., None] * br - ci[..., None] * bi
    bbi = cr[..., None] * bi + ci[..., None] * br
    return ar, ai, bbr, bbi


def complex_combine(e1, e2):
    a1r, a1i, b1r, b1i = e1
    a2r, a2i, b2r, b2i = e2
    return (a2r * a1r - a2i * a1i,
            a2r * a1i + a2i * a1r,
            a2r * b1r - a2i * b1i + b2r,
            a2r * b1i + a2i * b1r + b2i)


def ssm_segment(u, hr, hi, ar, ai, bbr, bbi, c_re, c_im):
    xr = jnp.einsum('btgc,gpc->btgp', u, bbr)
    xi = jnp.einsum('btgc,gpc->btgp', u, bbi)
    xr = xr.at[:, 0].add(ar * hr - ai * hi)
    xi = xi.at[:, 0].add(ar * hi + ai * hr)
    shp = xr.shape
    _, _, sr, si = lax.associative_scan(
        complex_combine, (jnp.broadcast_to(ar, shp), jnp.broadcast_to(ai, shp), xr, xi), axis=1)
    y = (jnp.einsum('btgp,gcp->btgc', sr, c_re.astype(jnp.float32))
         - jnp.einsum('btgp,gcp->btgc', si, c_im.astype(jnp.float32)))
    return y, sr[:, -1], si[:, -1]


def ssm_mixer(u, h0r, h0i, lam_re, lam_im, log_delta, b_re, b_im, c_re, c_im, d_skip):
    b, l, _ = u.shape
    uf = u.astype(jnp.float32)
    ar, ai, bbr, bbi = ssm_discretise(lam_re, lam_im, log_delta, b_re, b_im)
    chunk = SSM_CHUNK if l % SSM_CHUNK == 0 else l
    nc = l // chunk
    xs = uf.reshape(b, nc, chunk, SSM_GROUPS, SSM_GROUP).transpose(1, 0, 2, 3, 4)

    def step(carry, uc):
        y, hr, hi = ssm_segment(uc, carry[0], carry[1], ar, ai, bbr, bbi, c_re, c_im)
        return (hr, hi), y

    (hr, hi), ys = lax.scan(step, (h0r.astype(jnp.float32), h0i.astype(jnp.float32)), xs)
    y = ys.transpose(1, 0, 2, 3, 4).reshape(b, l, SSM_WIDTH)
    return y + d_skip.astype(jnp.float32) * uf, hr, hi


def decoder_layer(x, c, h0r, h0i, k_buf, v_buf, lp, rel_bias):
    (w_ada, b_ada, w_in, lam_re, lam_im, log_delta, b_re, b_im, c_re, c_im, d_skip,
     w_glu, b_glu, sinks, w_branch_s, w_branch_a, w_out, ln_g, ln_b) = lp
    b, l, _ = x.shape
    mod = jax.nn.silu(c) @ w_ada + b_ada
    shift, scale, gate = jnp.split(mod, 3, axis=-1)
    h = x * (1.0 + scale[:, None]) + shift[:, None]
    proj = h @ w_in
    points = [int(p) for p in np.cumsum(SPLITS)[:-1]]
    u_s, z_s, q, k, v, z_a, g_s, g_a = jnp.split(proj, points, axis=-1)
    y_s, hr, hi = ssm_mixer(u_s, h0r, h0i, lam_re, lam_im, log_delta, b_re, b_im, c_re, c_im, d_skip)
    y_s = jax.nn.gelu(y_s)
    y_s = y_s * jax.nn.sigmoid(y_s @ w_glu.astype(jnp.float32) + b_glu.astype(jnp.float32))
    y_s = (y_s * jax.nn.silu(z_s.astype(jnp.float32))).astype(x.dtype)
    b_s = y_s @ w_branch_s
    k = k.reshape(b, l, N_KV_HEADS, HEAD_DIM)
    v = v.reshape(b, l, N_KV_HEADS, HEAD_DIM)
    if k_buf is None:
        o_a = swa_prompt(q, k, v, sinks, rel_bias)
        new_k, new_v = k[:, -WINDOW:], v[:, -WINDOW:]
    else:
        o_a, new_k, new_v = swa_sample(q, k, v, k_buf, v_buf, sinks, rel_bias)
    b_a = (o_a * jax.nn.silu(z_a)) @ w_branch_a
    m = jax.nn.sigmoid(g_s) * b_s + jax.nn.sigmoid(g_a) * b_a
    out = m @ w_out
    y = layer_norm(DEEPNORM_ALPHA * x + gate[:, None] * out, ln_g, ln_b)
    return y, hr, hi, new_k, new_v


def setup_inputs(seed: int = 0) -> dict:
    key = jax.random.key(seed)
    ks = iter(jax.random.split(key, 40))
    nrm = lambda shape, s: jax.random.normal(next(ks), shape, jnp.float32) * s
    inputs = {}
    inputs['x_prompt'] = nrm((BATCH, SEQ, D_MODEL), 1.0)
    inputs['x_sample'] = nrm((DEC_BATCH, DEC_SEQ, D_MODEL), 1.0)
    inputs['c_prompt'] = nrm((BATCH, D_MODEL), 1.0)
    inputs['c_sample'] = nrm((DEC_BATCH, D_MODEL), 1.0)
    inputs['state_ssm_re'] = nrm((DEPTH, DEC_BATCH, SSM_GROUPS, SSM_STATE), 0.3)
    inputs['state_ssm_im'] = nrm((DEPTH, DEC_BATCH, SSM_GROUPS, SSM_STATE), 0.3)
    inputs['cache_swa_k'] = nrm((DEPTH, DEC_BATCH, WINDOW, N_KV_HEADS, HEAD_DIM), 1.0)
    inputs['cache_swa_v'] = nrm((DEPTH, DEC_BATCH, WINDOW, N_KV_HEADS, HEAD_DIM), 1.0)
    inputs['w_ada'] = nrm((DEPTH, D_MODEL, 3 * D_MODEL), 0.5 * D_MODEL ** -0.5)
    inputs['b_ada'] = nrm((DEPTH, 3 * D_MODEL), 0.02)
    inputs['w_in'] = nrm((DEPTH, D_MODEL, D_IN), D_MODEL ** -0.5)
    inputs['ssm_lambda_re'] = -0.5 + nrm((DEPTH, SSM_GROUPS, SSM_STATE), 0.01)
    inputs['ssm_lambda_im'] = (jnp.pi * jnp.arange(SSM_STATE, dtype=jnp.float32))[None, None] + nrm((DEPTH, SSM_GROUPS, SSM_STATE), 0.01)
    inputs['ssm_log_delta'] = jax.random.uniform(next(ks), (DEPTH, SSM_GROUPS), jnp.float32, math.log(1e-3), math.log(1e-1))
    inputs['ssm_b_re'] = nrm((DEPTH, SSM_GROUPS, SSM_STATE, SSM_GROUP), (2 * SSM_GROUP) ** -0.5)
    inputs['ssm_b_im'] = nrm((DEPTH, SSM_GROUPS, SSM_STATE, SSM_GROUP), (2 * SSM_GROUP) ** -0.5)
    inputs['ssm_c_re'] = nrm((DEPTH, SSM_GROUPS, SSM_GROUP, SSM_STATE), SSM_STATE ** -0.5)
    inputs['ssm_c_im'] = nrm((DEPTH, SSM_GROUPS, SSM_GROUP, SSM_STATE), SSM_STATE ** -0.5)
    inputs['ssm_d'] = nrm((DEPTH, SSM_WIDTH), 1.0)
    inputs['w_glu'] = nrm((DEPTH, SSM_WIDTH, SSM_WIDTH), SSM_WIDTH ** -0.5)
    inputs['b_glu'] = nrm((DEPTH, SSM_WIDTH), 0.02)
    inputs['attn_sinks'] = nrm((DEPTH, N_HEADS), 0.5)
    inputs['rel_bias'] = nrm((N_BUCKETS, N_HEADS), 0.1)
    inputs['w_branch_s'] = nrm((DEPTH, SSM_WIDTH, D_MODEL), SSM_WIDTH ** -0.5)
    inputs['w_branch_a'] = nrm((DEPTH, ATTN_WIDTH, D_MODEL), ATTN_WIDTH ** -0.5)
    inputs['w_out'] = nrm((DEPTH, D_MODEL, D_MODEL), DEEPNORM_BETA * D_MODEL ** -0.5)
    inputs['ln_g'] = 1.0 + nrm((DEPTH, D_MODEL), 0.02)
    inputs['ln_b'] = nrm((DEPTH, D_MODEL), 0.02)
    return inputs


def reference(x_prompt, x_sample, c_prompt, c_sample, state_ssm_re, state_ssm_im, cache_swa_k, cache_swa_v,
              w_ada, b_ada, w_in, ssm_lambda_re, ssm_lambda_im, ssm_log_delta, ssm_b_re, ssm_b_im,
              ssm_c_re, ssm_c_im, ssm_d, w_glu, b_glu, attn_sinks, rel_bias, w_branch_s, w_branch_a,
              w_out, ln_g, ln_b):
    yp, ys = x_prompt, x_sample
    p_hr, p_hi, p_k, p_v = [], [], [], []
    s_hr, s_hi, s_k, s_v = [], [], [], []
    zeros_state = jnp.zeros((x_prompt.shape[0], SSM_GROUPS, SSM_STATE), jnp.float32)
    for i in range(DEPTH):
        lp = (w_ada[i], b_ada[i], w_in[i], ssm_lambda_re[i], ssm_lambda_im[i], ssm_log_delta[i],
              ssm_b_re[i], ssm_b_im[i], ssm_c_re[i], ssm_c_im[i], ssm_d[i], w_glu[i], b_glu[i],
              attn_sinks[i], w_branch_s[i], w_branch_a[i], w_out[i], ln_g[i], ln_b[i])
        yp, hr, hi, nk, nv = decoder_layer(yp, c_prompt, zeros_state, zeros_state, None, None, lp, rel_bias)
        p_hr.append(hr); p_hi.append(hi); p_k.append(nk); p_v.append(nv)
        ys, hr, hi, nk, nv = decoder_layer(ys, c_sample, state_ssm_re[i], state_ssm_im[i],
                                           cache_swa_k[i], cache_swa_v[i], lp, rel_bias)
        s_hr.append(hr); s_hi.append(hi); s_k.append(nk); s_v.append(nv)
    return (yp, ys,
            jnp.stack(p_hr), jnp.stack(p_hi), jnp.stack(p_k), jnp.stack(p_v),
            jnp.stack(s_hr), jnp.stack(s_hi), jnp.stack(s_k), jnp.stack(s_v))
```

```cpp
#include <hip/hip_runtime.h>
#include <cstdio>
#include <cstdint>

typedef unsigned short bf16_t;

constexpr int D = 1024, BATCH = 2, SEQ = 8192, MP = BATCH * SEQ, MS = 128;
constexpr int DIN = 6656, NG = 64, NP = 64, GC = 16, NH = 16, HD = 64, NKV = 4, KVW = 256, WIN = 128;
constexpr float LN_EPS = 1e-5f, ALPHA = 1.189207115002721f, LOG2E = 1.4426950408889634f;
constexpr float QSCALE = 0.125f * LOG2E;

constexpr size_t OY_P = 0, OY_S = 16777216, OP_HR = 16908288, OP_HI = 16916480, OP_K = 16924672, OP_V = 16990208,
                 OS_HR = 17055744, OS_HI = 17580032, OS_K = 18104320, OS_V = 22298624, OUT_TOTAL = 26492928;

constexpr size_t MiB = 1u << 20;
constexpr size_t WS_CTL = 0;
constexpr size_t WS_MOD = 1 * MiB;
constexpr size_t WS_AR = 3 * MiB;
constexpr size_t WS_BBF = WS_AR + 4 * 16384;
constexpr size_t WS_BB = WS_BBF + 524288;
constexpr size_t WS_CMT = WS_BB + 262144;
constexpr size_t WS_BIAS = WS_CMT + 262144;
constexpr size_t WS_WIN = 8 * MiB;
constexpr size_t WS_WGLU = 21 * MiB, WS_WBS = 23 * MiB, WS_WBA = 25 * MiB, WS_WOUT = 27 * MiB;
constexpr size_t WS_E = 29 * MiB;
constexpr size_t WS_SAMPLE = 33 * MiB;
constexpr size_t WS_K = 36 * MiB;
constexpr size_t WS_VT = 44 * MiB;
constexpr size_t WS_US = 52 * MiB, WS_SZS = 84 * MiB, WS_Q = 116 * MiB, WS_SGS = 148 * MiB, WS_SGA = 180 * MiB, WS_SZA = 212 * MiB;
constexpr size_t WS_END = 244 * MiB;

__device__ __forceinline__ float bf2f(bf16_t v) { return __uint_as_float((unsigned)v << 16); }
__device__ __forceinline__ bf16_t f2bf(float f) { unsigned u = __float_as_uint(f); return (bf16_t)((u + 0x7fffu + ((u >> 16) & 1u)) >> 16); }
__device__ __forceinline__ float sigmoidf_(float x) { return 1.f / (1.f + __expf(-x)); }
__device__ __forceinline__ float siluf_(float x) { return x / (1.f + __expf(-x)); }
__device__ __forceinline__ float gelu_tanh(float x) { const float z = 0.7978845608028654f * (x + 0.044715f * x * x * x); return x * (1.f - 1.f / (1.f + __expf(2.f * z))); }

struct Rows {
    int M, is_sample;
    const float* x;
    bf16_t *H, *US, *SZS, *Q, *SZA, *SGS, *SGA, *YG, *V, *T1, *MM;
    float* y;
};
struct P {
    const float* in[28];
    float* out;
    unsigned char* ws;
    Rows rp, rs;
    float* mod;
    float *ar, *ai, *atr, *ati, *bbf; bf16_t *bb, *cmt; float* biasl;
    bf16_t *win, *wglu, *wbs, *wba, *wout;
    float* E; bf16_t *K, *VT;
};
__device__ __forceinline__ int modrow(const Rows& r, int row) { return r.is_sample ? 2 + row : row / SEQ; }

__global__ void k_mod(P p) {
    const int idx = blockIdx.x * blockDim.x + threadIdx.x;
    if (idx >= 130 * 3072) return;
    const int r = idx / 3072, n = idx % 3072;
    const float* c = r < 2 ? p.in[2] + (size_t)r * D : p.in[3] + (size_t)(r - 2) * D;
    const float* w = p.in[8];
    float acc = p.in[9][n];
    for (int k = 0; k < D; ++k) acc += siluf_(c[k]) * w[(size_t)k * 3072 + n];
    p.mod[idx] = acc;
}
__global__ void k_tables(P p) {
    const int idx = blockIdx.x * blockDim.x + threadIdx.x;
    if (idx < NG * NP) {
        const int g = idx / NP;
        const double lr = p.in[11][idx], li = p.in[12][idx], dt = exp((double)p.in[13][g]);
        const double mag = exp(lr * dt), ar = mag * cos(li * dt), ai = mag * sin(li * dt);
        const double den = lr * lr + li * li, nr = ar - 1.0, cr = (nr * lr + ai * li) / den, ci = (ai * lr - nr * li) / den;
        p.ar[idx] = (float)ar; p.ai[idx] = (float)ai;
        double pr = ar, pi = ai;
        for (int s = 0; s < 7; ++s) { const double nr2 = pr * pr - pi * pi, ni2 = 2.0 * pr * pi; pr = nr2; pi = ni2; }
        p.atr[idx] = (float)pr; p.ati[idx] = (float)pi;
        const int pp = idx % NP;
        for (int c = 0; c < GC; ++c) {
            const double br = p.in[14][(size_t)idx * GC + c], bi = p.in[15][(size_t)idx * GC + c];
            const float bbr = (float)(cr * br - ci * bi), bbi = (float)(cr * bi + ci * br);
            p.bbf[((size_t)(g * 2 + 0) * NP + pp) * GC + c] = bbr; p.bbf[((size_t)(g * 2 + 1) * NP + pp) * GC + c] = bbi;
            p.bb[((size_t)(g * 2 + 0) * NP + pp) * GC + c] = f2bf(bbr); p.bb[((size_t)(g * 2 + 1) * NP + pp) * GC + c] = f2bf(bbi);
            p.cmt[((size_t)g * GC + c) * 128 + 2 * pp + 0] = f2bf(p.in[16][((size_t)g * GC + c) * NP + pp]);
            p.cmt[((size_t)g * GC + c) * 128 + 2 * pp + 1] = f2bf(-p.in[17][((size_t)g * GC + c) * NP + pp]);
        }
    }
    if (idx < NH * 132) {
        const int h = idx / 132, d = idx % 132;
        float v = 0.f;
        if (d <= 128) {
            int bucket;
            if (d < 16) bucket = d;
            else { const float df = (float)d; int large = 16 + (int)(logf(df / 16.f) / logf(8.f) * 16.f); bucket = large < 31 ? large : 31; }
            v = p.in[22][bucket * NH + h] * LOG2E;
        }
        p.biasl[idx] = v;
    }
    if (idx < NH) p.biasl[NH * 132 + idx] = p.in[21][idx] * LOG2E;
}
__global__ void k_transpose(const float* W, bf16_t* WT, int K, int N) {
    const size_t idx = (size_t)blockIdx.x * blockDim.x + threadIdx.x;
    if (idx >= (size_t)K * N) return;
    const int n = (int)(idx / K), k = (int)(idx % K);
    WT[idx] = f2bf(W[(size_t)k * N + n]);
}
__global__ void k_h(P p, Rows r) {
    const size_t idx = (size_t)blockIdx.x * blockDim.x + threadIdx.x;
    if (idx >= (size_t)r.M * D) return;
    const int row = (int)(idx / D), k = (int)(idx % D);
    const float* m = p.mod + (size_t)modrow(r, row) * 3072;
    r.H[idx] = f2bf(r.x[idx] * (1.f + m[1024 + k]) + m[k]);
}
struct EpiInproj {
    P pp; int sample, pad;
    __device__ void operator()(int row, int col, float v) const {
        const P* p = &pp; const Rows& R = sample ? pp.rs : pp.rp;
        if (col < 1024) R.US[(size_t)row * D + col] = f2bf(v);
        else if (col < 2048) R.SZS[(size_t)row * D + col - 1024] = f2bf(siluf_(v));
        else if (col < 3072) R.Q[(size_t)row * D + col - 2048] = f2bf(v * QSCALE);
        else if (col < 3328) {
            const int c = col - 3072;
            if (R.is_sample) p->out[OS_K + ((size_t)row * WIN + 127) * KVW + c] = v;
            else { p->K[(size_t)row * KVW + c] = f2bf(v); const int b = row / SEQ, t = row % SEQ; if (t >= SEQ - WIN) p->out[OP_K + ((size_t)b * WIN + t - (SEQ - WIN)) * KVW + c] = v; }
        } else if (col < 3584) {
            const int c = col - 3328;
            if (R.is_sample) p->out[OS_V + ((size_t)row * WIN + 127) * KVW + c] = v;
            else { const int b = row / SEQ, t = row % SEQ; p->VT[((size_t)(b * NKV + (c >> 6)) * HD + (c & 63)) * SEQ + t] = f2bf(v); if (t >= SEQ - WIN) p->out[OP_V + ((size_t)b * WIN + t - (SEQ - WIN)) * KVW + c] = v; }
        } else if (col < 4608) R.SZA[(size_t)row * D + col - 3584] = f2bf(siluf_(v));
        else if (col < 5632) R.SGS[(size_t)row * D + col - 4608] = f2bf(sigmoidf_(v));
        else R.SGA[(size_t)row * D + col - 5632] = f2bf(sigmoidf_(v));
    }
};
struct EpiGlu {
    const float* bglu; Rows rr;
    __device__ void operator()(int row, int col, float v) const {
        const Rows* r = &rr; const size_t i = (size_t)row * D + col;
        r->V[i] = f2bf(bf2f(r->YG[i]) * sigmoidf_(v + bglu[col]) * bf2f(r->SZS[i]));
    }
};
struct EpiBa {
    Rows rr;
    __device__ void operator()(int row, int col, float v) const { const Rows* r = &rr; const size_t i = (size_t)row * D + col; r->T1[i] = f2bf(bf2f(r->SGA[i]) * v); }
};
struct EpiBs {
    Rows rr;
    __device__ void operator()(int row, int col, float v) const { const Rows* r = &rr; const size_t i = (size_t)row * D + col; r->MM[i] = f2bf(bf2f(r->SGS[i]) * v + bf2f(r->T1[i])); }
};
struct EpiOut {
    const float* mod; Rows rr;
    __device__ void operator()(int row, int col, float v) const {
        const Rows* r = &rr; const size_t i = (size_t)row * D + col;
        r->y[i] = ALPHA * r->x[i] + mod[(size_t)modrow(*r, row) * 3072 + 2048 + col] * v;
    }
};
template <class Epi>
__global__ void k_gemm_naive(const bf16_t* A, const bf16_t* Bt, int M, int N, int K, int pad, Epi epi) {
    const size_t idx = (size_t)blockIdx.x * blockDim.x + threadIdx.x;
    if (idx >= (size_t)M * N) return;
    const int row = (int)(idx / N), col = (int)(idx % N);
    const uint4* a = (const uint4*)(A + (size_t)row * K); const uint4* b = (const uint4*)(Bt + (size_t)col * K);
    float acc = 0.f;
    for (int k = 0; k < K / 8; ++k) {
        const uint4 av = a[k], bv = b[k];
        const unsigned aw[4] = {av.x, av.y, av.z, av.w}, bw[4] = {bv.x, bv.y, bv.z, bv.w};
#pragma unroll
        for (int j = 0; j < 4; ++j) { acc += __uint_as_float(aw[j] << 16) * __uint_as_float(bw[j] << 16); acc += __uint_as_float(aw[j] & 0xffff0000u) * __uint_as_float(bw[j] & 0xffff0000u); }
    }
    epi(row, col, acc);
}
__global__ void __launch_bounds__(64) k_ssm_naive(P p, Rows r, int T, int pad) {
    const int lane = threadIdx.x, g = blockIdx.x % NG, b = blockIdx.x / NG;
    const int gp = g * NP + lane;
    const float ar = p.ar[gp], ai = p.ai[gp];
    float bbr[GC], bbi[GC], cre[GC], cim[GC];
#pragma unroll
    for (int c = 0; c < GC; ++c) {
        bbr[c] = p.bbf[((size_t)(g * 2 + 0) * NP + lane) * GC + c]; bbi[c] = p.bbf[((size_t)(g * 2 + 1) * NP + lane) * GC + c];
        cre[c] = p.in[16][((size_t)g * GC + c) * NP + lane]; cim[c] = p.in[17][((size_t)g * GC + c) * NP + lane];
    }
    float hr = 0.f, hi = 0.f;
    if (r.is_sample) { hr = p.in[4][((size_t)b * NG + g) * NP + lane]; hi = p.in[5][((size_t)b * NG + g) * NP + lane]; }
    const float dsk = p.in[18][g * GC + (lane & 15)];
    for (int t = 0; t < T; ++t) {
        const size_t row = (size_t)b * T + t;
        const bf16_t* u = r.US + row * D + g * GC;
        float xr = 0.f, xi = 0.f, uu[GC];
#pragma unroll
        for (int c = 0; c < GC; ++c) { uu[c] = bf2f(u[c]); xr += bbr[c] * uu[c]; xi += bbi[c] * uu[c]; }
        const float nhr = ar * hr - ai * hi + xr, nhi = ar * hi + ai * hr + xi; hr = nhr; hi = nhi;
        float mine = 0.f, myu = 0.f;
#pragma unroll
        for (int c = 0; c < GC; ++c) {
            float v = cre[c] * hr - cim[c] * hi;
#pragma unroll
            for (int o = 1; o < 64; o <<= 1) v += __shfl_xor(v, o);
            if ((lane & 15) == c) { mine = v; myu = uu[c]; }
        }
        if (lane < GC) r.YG[row * D + g * GC + lane] = f2bf(gelu_tanh(mine + dsk * myu));
    }
    float* ohr = p.out + (r.is_sample ? OS_HR : OP_HR); float* ohi = p.out + (r.is_sample ? OS_HI : OP_HI);
    ohr[((size_t)b * NG + g) * NP + lane] = hr; ohi[((size_t)b * NG + g) * NP + lane] = hi;
}
__global__ void __launch_bounds__(64) k_attn_naive(P p) {
    const int idx = blockIdx.x * blockDim.x + threadIdx.x;
    if (idx >= NH * MP) return;
    const int head = idx / MP, row = idx % MP, b = row / SEQ, t = row % SEQ, kvh = head >> 2;
    const Rows& R = p.rp;
    float q[HD], o[HD];
#pragma unroll
    for (int d = 0; d < HD; ++d) { q[d] = bf2f(R.Q[(size_t)row * D + head * HD + d]); o[d] = 0.f; }
    const float sink = p.biasl[NH * 132 + head];
    float m = sink, l = 1.f;
    const int k0 = t - WIN < 0 ? 0 : t - WIN;
    for (int kp = k0; kp <= t; ++kp) {
        const bf16_t* kr = p.K + (size_t)(b * SEQ + kp) * KVW + kvh * HD;
        float s = 0.f;
#pragma unroll
        for (int d = 0; d < HD; ++d) s += q[d] * bf2f(kr[d]);
        s += p.biasl[head * 132 + (t - kp)];
        const float mn = fmaxf(m, s), f = exp2f(m - mn), pe = exp2f(s - mn);
        l = l * f + pe; m = mn;
        const bf16_t* vt = p.VT + ((size_t)(b * NKV + kvh) * HD) * SEQ + kp;
#pragma unroll
        for (int d = 0; d < HD; ++d) o[d] = o[d] * f + pe * bf2f(vt[(size_t)d * SEQ]);
    }
    const float inv = 1.f / l;
#pragma unroll
    for (int d = 0; d < HD; ++d) { const size_t i = (size_t)row * D + head * HD + d; R.Q[i] = f2bf(o[d] * inv * bf2f(R.SZA[i])); }
}
__global__ void k_cache_shift(P p) {
    const size_t idx = (size_t)blockIdx.x * blockDim.x + threadIdx.x;
    if (idx >= (size_t)MS * 127 * KVW) return;
    const int b = (int)(idx / (127 * KVW)), rem = (int)(idx % (127 * KVW));
    p.out[OS_K + (size_t)b * WIN * KVW + rem] = p.in[6][(size_t)b * WIN * KVW + KVW + rem];
    p.out[OS_V + (size_t)b * WIN * KVW + rem] = p.in[7][(size_t)b * WIN * KVW + KVW + rem];
}
__global__ void __launch_bounds__(64) k_attn_sample_naive(P p) {
    const int idx = blockIdx.x * blockDim.x + threadIdx.x;
    if (idx >= MS * NH) return;
    const int b = idx / NH, head = idx % NH, kvh = head >> 2;
    const Rows& R = p.rs;
    float q[HD], o[HD];
#pragma unroll
    for (int d = 0; d < HD; ++d) { q[d] = bf2f(R.Q[(size_t)b * D + head * HD + d]); o[d] = 0.f; }
    const float sink = p.biasl[NH * 132 + head];
    float m = sink, l = 1.f;
    for (int j = 0; j <= WIN; ++j) {
        const float* kr = j < WIN ? p.in[6] + ((size_t)b * WIN + j) * KVW + kvh * HD : p.out + OS_K + ((size_t)b * WIN + 127) * KVW + kvh * HD;
        const float* vr = j < WIN ? p.in[7] + ((size_t)b * WIN + j) * KVW + kvh * HD : p.out + OS_V + ((size_t)b * WIN + 127) * KVW + kvh * HD;
        float s = 0.f;
#pragma unroll
        for (int d = 0; d < HD; ++d) s += q[d] * kr[d];
        s += p.biasl[head * 132 + (WIN - j)];
        const float mn = fmaxf(m, s), f = exp2f(m - mn), pe = exp2f(s - mn);
        l = l * f + pe; m = mn;
#pragma unroll
        for (int d = 0; d < HD; ++d) o[d] = o[d] * f + pe * vr[d];
    }
    const float inv = 1.f / l;
#pragma unroll
    for (int d = 0; d < HD; ++d) { const size_t i = (size_t)b * D + head * HD + d; R.Q[i] = f2bf(o[d] * inv * bf2f(R.SZA[i])); }
}
__global__ void k_ln(P p, Rows r) {
    const int lane = threadIdx.x & 63, row = blockIdx.x * (blockDim.x / 64) + (threadIdx.x >> 6);
    if (row >= r.M) return;
    float* y = r.y + (size_t)row * D;
    float v[16], s = 0.f;
#pragma unroll
    for (int j = 0; j < 16; ++j) { v[j] = y[lane + 64 * j]; s += v[j]; }
#pragma unroll
    for (int o = 1; o < 64; o <<= 1) s += __shfl_xor(s, o);
    const float mean = s * (1.f / D); float q = 0.f;
#pragma unroll
    for (int j = 0; j < 16; ++j) { v[j] -= mean; q += v[j] * v[j]; }
#pragma unroll
    for (int o = 1; o < 64; o <<= 1) q += __shfl_xor(q, o);
    const float rstd = 1.f / sqrtf(q * (1.f / D) + LN_EPS);
#pragma unroll
    for (int j = 0; j < 16; ++j) { const int c = lane + 64 * j; y[c] = v[j] * rstd * p.in[26][c] + p.in[27][c]; }
}

static void fill_params(P& p, void* const* d_in, void* d_out, void* d_ws) {
    for (int i = 0; i < 28; ++i) p.in[i] = (const float*)d_in[i];
    p.out = (float*)d_out; p.ws = (unsigned char*)d_ws;
    unsigned char* ws = p.ws;
    p.mod = (float*)(ws + WS_MOD);
    p.ar = (float*)(ws + WS_AR); p.ai = p.ar + 4096; p.atr = p.ar + 8192; p.ati = p.ar + 12288;
    p.bbf = (float*)(ws + WS_BBF); p.bb = (bf16_t*)(ws + WS_BB); p.cmt = (bf16_t*)(ws + WS_CMT); p.biasl = (float*)(ws + WS_BIAS);
    p.win = (bf16_t*)(ws + WS_WIN); p.wglu = (bf16_t*)(ws + WS_WGLU); p.wbs = (bf16_t*)(ws + WS_WBS); p.wba = (bf16_t*)(ws + WS_WBA); p.wout = (bf16_t*)(ws + WS_WOUT);
    p.E = (float*)(ws + WS_E); p.K = (bf16_t*)(ws + WS_K); p.VT = (bf16_t*)(ws + WS_VT);
    Rows& a = p.rp; a.M = MP; a.is_sample = 0; a.x = p.in[0];
    a.H = (bf16_t*)d_out;
    a.YG = (bf16_t*)d_out;
    a.US = (bf16_t*)(ws + WS_US); a.SZS = (bf16_t*)(ws + WS_SZS); a.Q = (bf16_t*)(ws + WS_Q); a.SZA = (bf16_t*)(ws + WS_SZA);
    a.SGS = (bf16_t*)(ws + WS_SGS); a.SGA = (bf16_t*)(ws + WS_SGA);
    a.V = a.US; a.T1 = a.SZA; a.MM = a.SZS; a.y = p.out + OY_P;
    Rows& s = p.rs; s.M = MS; s.is_sample = 1; s.x = p.in[1];
    bf16_t* sb = (bf16_t*)(ws + WS_SAMPLE); const size_t SB = (size_t)MS * D;
    s.H = sb; s.US = sb + SB; s.SZS = sb + 2 * SB; s.Q = sb + 3 * SB; s.SZA = sb + 4 * SB; s.SGS = sb + 5 * SB; s.SGA = sb + 6 * SB;
    s.YG = sb + 7 * SB; s.V = sb + 8 * SB; s.T1 = sb + 9 * SB; s.MM = sb + 10 * SB; s.y = p.out + OY_S;
}
template <class Epi>
static void gemm_naive(hipStream_t st, const bf16_t* A, const bf16_t* Bt, int M, int N, int K, Epi e) {
    const size_t tot = (size_t)M * N;
    hipLaunchKernelGGL(k_gemm_naive<Epi>, dim3((unsigned)((tot + 255) / 256)), dim3(256), 0, st, A, Bt, M, N, K, 0, e);
}
extern "C" void kernel_launch(void* const* d_in, const int* in_sizes, int n_in, void* d_out, int out_size, void* d_ws, size_t ws_size, hipStream_t stream) {
    if (n_in != 28 || (size_t)out_size != OUT_TOTAL || ws_size < WS_END) { fprintf(stderr, "kernel_launch: unexpected shapes n_in %d out %d ws %zu\n", n_in, out_size, ws_size); return; }
    P p{}; fill_params(p, d_in, d_out, d_ws);
    const Rows drp = p.rp, drs = p.rs;
    hipLaunchKernelGGL(k_mod, dim3((130 * 3072 + 255) / 256), dim3(256), 0, stream, p);
    hipLaunchKernelGGL(k_tables, dim3(16), dim3(256), 0, stream, p);
    hipLaunchKernelGGL(k_transpose, dim3((unsigned)(((size_t)D * DIN + 255) / 256)), dim3(256), 0, stream, p.in[10], p.win, D, DIN);
    hipLaunchKernelGGL(k_transpose, dim3(4096), dim3(256), 0, stream, p.in[19], p.wglu, D, D);
    hipLaunchKernelGGL(k_transpose, dim3(4096), dim3(256), 0, stream, p.in[23], p.wbs, D, D);
    hipLaunchKernelGGL(k_transpose, dim3(4096), dim3(256), 0, stream, p.in[24], p.wba, D, D);
    hipLaunchKernelGGL(k_transpose, dim3(4096), dim3(256), 0, stream, p.in[25], p.wout, D, D);
    hipLaunchKernelGGL(k_h, dim3((unsigned)(((size_t)MP * D + 255) / 256)), dim3(256), 0, stream, p, p.rp);
    hipLaunchKernelGGL(k_h, dim3((unsigned)(((size_t)MS * D + 255) / 256)), dim3(256), 0, stream, p, p.rs);
    hipLaunchKernelGGL(k_cache_shift, dim3((unsigned)(((size_t)MS * 127 * KVW + 255) / 256)), dim3(256), 0, stream, p);
    gemm_naive(stream, p.rp.H, p.win, MP, DIN, D, EpiInproj{p, 0, 0});
    gemm_naive(stream, p.rs.H, p.win, MS, DIN, D, EpiInproj{p, 1, 0});
    hipLaunchKernelGGL(k_ssm_naive, dim3(BATCH * NG), dim3(64), 0, stream, p, p.rp, SEQ, 0);
    hipLaunchKernelGGL(k_ssm_naive, dim3(MS * NG), dim3(64), 0, stream, p, p.rs, 1, 0);
    hipLaunchKernelGGL(k_attn_naive, dim3((NH * MP + 63) / 64), dim3(64), 0, stream, p);
    hipLaunchKernelGGL(k_attn_sample_naive, dim3((MS * NH + 63) / 64), dim3(64), 0, stream, p);
    gemm_naive(stream, p.rp.YG, p.wglu, MP, D, D, EpiGlu{p.in[20], drp});
    gemm_naive(stream, p.rs.YG, p.wglu, MS, D, D, EpiGlu{p.in[20], drs});
    gemm_naive(stream, p.rp.Q, p.wba, MP, D, D, EpiBa{drp});
    gemm_naive(stream, p.rs.Q, p.wba, MS, D, D, EpiBa{drs});
    gemm_naive(stream, p.rp.V, p.wbs, MP, D, D, EpiBs{drp});
    gemm_naive(stream, p.rs.V, p.wbs, MS, D, D, EpiBs{drs});
    gemm_naive(stream, p.rp.MM, p.wout, MP, D, D, EpiOut{p.mod, drp});
    gemm_naive(stream, p.rs.MM, p.wout, MS, D, D, EpiOut{p.mod, drs});
    hipLaunchKernelGGL(k_ln, dim3(MP / 4), dim3(256), 0, stream, p, p.rp);
    hipLaunchKernelGGL(k_ln, dim3(MS / 4), dim3(256), 0, stream, p, p.rs);
}
```

```cpp
#include <hip/hip_runtime.h>
#include <cstdio>
#include <cstdint>

typedef unsigned short bf16_t;

constexpr int D = 1024, BATCH = 2, SEQ = 8192, MP = BATCH * SEQ, MS = 128;
constexpr int DIN = 6656, NG = 64, NP = 64, GC = 16, NH = 16, HD = 64, NKV = 4, KVW = 256, WIN = 128;
constexpr float LN_EPS = 1e-5f, ALPHA = 1.189207115002721f, LOG2E = 1.4426950408889634f;
constexpr float QSCALE = 0.125f * LOG2E;

constexpr size_t OY_P = 0, OY_S = 16777216, OP_HR = 16908288, OP_HI = 16916480, OP_K = 16924672, OP_V = 16990208,
                 OS_HR = 17055744, OS_HI = 17580032, OS_K = 18104320, OS_V = 22298624, OUT_TOTAL = 26492928;

constexpr size_t MiB = 1u << 20;
constexpr size_t WS_CTL = 0;
constexpr size_t WS_MOD = 1 * MiB;
constexpr size_t WS_AR = 3 * MiB;
constexpr size_t WS_BBF = WS_AR + 4 * 16384;
constexpr size_t WS_BB = WS_BBF + 524288;
constexpr size_t WS_CMT = WS_BB + 262144;
constexpr size_t WS_BIAS = WS_CMT + 262144;
constexpr size_t WS_WIN = 8 * MiB;
constexpr size_t WS_WGLU = 21 * MiB, WS_WBS = 23 * MiB, WS_WBA = 25 * MiB, WS_WOUT = 27 * MiB;
constexpr size_t WS_E = 29 * MiB;
constexpr size_t WS_SAMPLE = 33 * MiB;
constexpr size_t WS_K = 36 * MiB;
constexpr size_t WS_VT = 44 * MiB;
constexpr size_t WS_US = 52 * MiB, WS_SZS = 84 * MiB, WS_Q = 116 * MiB, WS_SGS = 148 * MiB, WS_SGA = 180 * MiB, WS_SZA = 212 * MiB;
constexpr size_t WS_END = 244 * MiB;

__device__ __forceinline__ float bf2f(bf16_t v) { return __uint_as_float((unsigned)v << 16); }
__device__ __forceinline__ bf16_t f2bf(float f) { unsigned u = __float_as_uint(f); return (bf16_t)((u + 0x7fffu + ((u >> 16) & 1u)) >> 16); }
__device__ __forceinline__ float sigmoidf_(float x) { return 1.f / (1.f + __expf(-x)); }
__device__ __forceinline__ float siluf_(float x) { return x / (1.f + __expf(-x)); }
__device__ __forceinline__ float gelu_tanh(float x) { const float z = 0.7978845608028654f * (x + 0.044715f * x * x * x); return x * (1.f - 1.f / (1.f + __expf(2.f * z))); }

struct Rows {
    int M, is_sample;
    const float* x;
    bf16_t *H, *US, *SZS, *Q, *SZA, *SGS, *SGA, *YG, *V, *T1, *MM;
    float* y;
};
struct P {
    const float* in[28];
    float* out;
    unsigned char* ws;
    Rows rp, rs;
    float* mod;
    float *ar, *ai, *atr, *ati, *bbf; bf16_t *bb, *cmt; float* biasl;
    bf16_t *win, *wglu, *wbs, *wba, *wout;
    float* E; bf16_t *K, *VT;
};
__device__ __forceinline__ int modrow(const Rows& r, int row) { return r.is_sample ? 2 + row : row / SEQ; }

namespace pg8 {
#define PG8_LAS __attribute__((address_space(3)))
typedef unsigned short bf16_t;
typedef short bf16x8 __attribute__((ext_vector_type(8)));
typedef float f32x4 __attribute__((ext_vector_type(4)));
typedef unsigned u32x4 __attribute__((ext_vector_type(4)));
constexpr int BM = 256, BK = 64, HALF = 128, HTB = HALF * BK * 2  , STAGE_BYTES = 8 * HTB, NXCD = 8, WGM = 8;

__host__ __device__ __forceinline__ int lds_byte(int r, int c) { const int st = (r >> 4) * 2 + (c >> 5), rr = r & 15, cc = c & 31, ob = rr * 64 + cc * 2; return st * 1024 + (ob ^ (((ob >> 9) & 1) << 5)); }
__host__ __device__ __forceinline__ void stage_rc(int b, int& R, int& C) { const int st = b / 1024, sb = b % 1024, swz = sb ^ (((sb >> 9) & 1) << 5); R = (st >> 1) * 16 + swz / 64; C = (st & 1) * 32 + (swz % 64) / 2; }
__host__ __device__ __forceinline__ int perm32(int rho) { const int n = rho >> 4, i = rho & 15; return 8 * (i >> 2) + 4 * n + (i & 3); }

struct Unit { int pm, pn; };
struct Gemm { const bf16_t* A; const bf16_t* Bt; int M, N, K; };

struct StaticOrder {
    int nM, nN, nwg, G, c;
    __host__ __device__ void init(int M, int N, int G_, int c_) { nM = M / BM; nN = N / BM; nwg = nM * nN; G = G_; c = c_; }
    __host__ __device__ bool next(int i, Unit& u) const {
        const long L = (long)i * G + c; if (L >= nwg) return false;
        int wgid = (int)L; { const int q = nwg / NXCD, r = nwg % NXCD, xcd = wgid % NXCD, off = wgid / NXCD; wgid = (xcd < r ? xcd * (q + 1) : r * (q + 1) + (xcd - r) * q) + off; }
        const int nig = WGM * nN, gid = wgid / nig, fm = gid * WGM, gsz = (nM - fm) < WGM ? (nM - fm) : WGM;
        u.pm = fm + ((wgid % nig) % gsz); u.pn = (wgid % nig) / gsz; return true;
    }
    __device__ __forceinline__ void a_ready(const Unit&) const {}
    __device__ __forceinline__ void done(const Unit&) const {}
};

__device__ __forceinline__ unsigned cvt_pk_bf16(float lo, float hi) { unsigned r; asm volatile("v_cvt_pk_bf16_f32 %0, %1, %2" : "=v"(r) : "v"(lo), "v"(hi)); return r; }
typedef float f32x2 __attribute__((ext_vector_type(2)));
__device__ __forceinline__ float sig_(float x) { return 1.f / (1.f + __expf(-x)); }
__device__ __forceinline__ u32x4 pack8(const f32x4& a, const f32x4& b) { u32x4 w; w.x = cvt_pk_bf16(a[0], a[1]); w.y = cvt_pk_bf16(a[2], a[3]); w.z = cvt_pk_bf16(b[0], b[1]); w.w = cvt_pk_bf16(b[2], b[3]); return w; }
__device__ __forceinline__ void unpack8(const u32x4& w, f32x4& a, f32x4& b) {
    a[0] = __uint_as_float(w.x << 16); a[1] = __uint_as_float(w.x & 0xffff0000u); a[2] = __uint_as_float(w.y << 16); a[3] = __uint_as_float(w.y & 0xffff0000u);
    b[0] = __uint_as_float(w.z << 16); b[1] = __uint_as_float(w.z & 0xffff0000u); b[2] = __uint_as_float(w.w << 16); b[3] = __uint_as_float(w.w & 0xffff0000u);
}
struct EpiInprojFast {
    static constexpr bool PERM = true, AFTER_DRAIN = false;
    bf16_t *US, *SZS, *Q, *SZA, *SGS, *SGA, *K, *VT; float* out;
    __device__ __forceinline__ void operator()(const f32x4 (&acc)[2][2][4][2], const Unit& u, int wr, int wc, int fr, int fq) const {
        const int pn = u.pn, row0 = u.pm * BM + wr * 64 + fr, cl0 = wc * 32 + 8 * fq;
        const int b = u.pm >> 5, tb = (u.pm & 31) * BM + wr * 64 + fr;
        if (pn == 13) {
#pragma unroll
            for (int ai = 0; ai < 2; ++ai)
#pragma unroll
                for (int m = 0; m < 4; ++m) { const int t = tb + ai * HALF + m * 16;
#pragma unroll
                    for (int bj = 0; bj < 2; ++bj)
#pragma unroll
                        for (int n = 0; n < 2; ++n)
#pragma unroll
                            for (int e = 0; e < 4; ++e) { const int c = bj * HALF + cl0 + 4 * n + e;
                                VT[((size_t)(b * NKV + (c >> 6)) * HD + (c & 63)) * SEQ + t] = (bf16_t)(cvt_pk_bf16(acc[ai][bj][m][n][e], 0.f) & 0xffffu); }
                    if (ai == 1 && (u.pm & 31) == 31) { float* o = out + OP_V + ((size_t)(b * WIN) + (wr * 64 + m * 16 + fr)) * KVW + cl0;
#pragma unroll
                        for (int bj = 0; bj < 2; ++bj) { *(f32x4*)(o + bj * HALF) = acc[ai][bj][m][0]; *(f32x4*)(o + bj * HALF + 4) = acc[ai][bj][m][1]; } } }
            return;
        }
        bf16_t* base; int ld = D, colt, mode;
        if (pn < 4) { base = US; colt = pn * BM; mode = 0; }
        else if (pn < 8) { base = SZS; colt = (pn - 4) * BM; mode = 1; }
        else if (pn < 12) { base = Q; colt = (pn - 8) * BM; mode = 3; }
        else if (pn == 12) { base = K; colt = 0; mode = 0; ld = KVW; }
        else if (pn < 18) { base = SZA; colt = (pn - 14) * BM; mode = 1; }
        else if (pn < 22) { base = SGS; colt = (pn - 18) * BM; mode = 2; }
        else { base = SGA; colt = (pn - 22) * BM; mode = 2; }
#pragma unroll
        for (int ai = 0; ai < 2; ++ai)
#pragma unroll
            for (int m = 0; m < 4; ++m) { bf16_t* rowp = base + (size_t)(row0 + ai * HALF + m * 16) * ld + colt + cl0;
#pragma unroll
                for (int bj = 0; bj < 2; ++bj) { f32x4 v0 = acc[ai][bj][m][0], v1 = acc[ai][bj][m][1];
                    if (mode == 1) {
#pragma unroll
                        for (int e = 0; e < 4; ++e) { v0[e] = v0[e] * sig_(v0[e]); v1[e] = v1[e] * sig_(v1[e]); } }
                    else if (mode == 2) {
#pragma unroll
                        for (int e = 0; e < 4; ++e) { v0[e] = sig_(v0[e]); v1[e] = sig_(v1[e]); } }
                    else if (mode == 3) { v0 = v0 * QSCALE; v1 = v1 * QSCALE; }
                    *(u32x4*)(rowp + bj * HALF) = pack8(v0, v1); }
                if (pn == 12 && ai == 1 && (u.pm & 31) == 31) { float* o = out + OP_K + ((size_t)(b * WIN) + (wr * 64 + m * 16 + fr)) * KVW + cl0;
#pragma unroll
                    for (int bj = 0; bj < 2; ++bj) { *(f32x4*)(o + bj * HALF) = acc[ai][bj][m][0]; *(f32x4*)(o + bj * HALF + 4) = acc[ai][bj][m][1]; } } }
    }
};
struct EpiGluFast {
    static constexpr bool PERM = true, AFTER_DRAIN = false;
    const bf16_t *YG, *SZS; bf16_t* V; const float* bglu;
    __device__ __forceinline__ void operator()(const f32x4 (&acc)[2][2][4][2], const Unit& u, int wr, int wc, int fr, int fq) const {
        const int row0 = u.pm * BM + wr * 64 + fr, col0 = u.pn * BM + wc * 32 + 8 * fq;
        f32x4 bv[2][2];
#pragma unroll
        for (int bj = 0; bj < 2; ++bj)
#pragma unroll
            for (int n = 0; n < 2; ++n) bv[bj][n] = *(const f32x4*)(bglu + col0 + bj * HALF + 4 * n);
#pragma unroll
        for (int ai = 0; ai < 2; ++ai)
#pragma unroll
            for (int m = 0; m < 4; ++m) { const size_t off = (size_t)(row0 + ai * HALF + m * 16) * D + col0;
#pragma unroll
                for (int bj = 0; bj < 2; ++bj) { f32x4 y0, y1, z0, z1; unpack8(*(const u32x4*)(YG + off + bj * HALF), y0, y1); unpack8(*(const u32x4*)(SZS + off + bj * HALF), z0, z1);
                    f32x4 v0 = acc[ai][bj][m][0] + bv[bj][0], v1 = acc[ai][bj][m][1] + bv[bj][1];
#pragma unroll
                    for (int e = 0; e < 4; ++e) { v0[e] = y0[e] * sig_(v0[e]) * z0[e]; v1[e] = y1[e] * sig_(v1[e]) * z1[e]; }
                    *(u32x4*)(V + off + bj * HALF) = pack8(v0, v1); } }
    }
};
template <bool HAS_ADD> struct EpiGateFast {
    static constexpr bool PERM = true, AFTER_DRAIN = false;
    const bf16_t *G, *ADD; bf16_t* O;
    __device__ __forceinline__ void operator()(const f32x4 (&acc)[2][2][4][2], const Unit& u, int wr, int wc, int fr, int fq) const {
        const int row0 = u.pm * BM + wr * 64 + fr, col0 = u.pn * BM + wc * 32 + 8 * fq;
#pragma unroll
        for (int ai = 0; ai < 2; ++ai)
#pragma unroll
            for (int m = 0; m < 4; ++m) { const size_t off = (size_t)(row0 + ai * HALF + m * 16) * D + col0;
#pragma unroll
                for (int bj = 0; bj < 2; ++bj) { f32x4 g0, g1; unpack8(*(const u32x4*)(G + off + bj * HALF), g0, g1);
                    f32x4 v0 = acc[ai][bj][m][0] * g0, v1 = acc[ai][bj][m][1] * g1;
                    if (HAS_ADD) { f32x4 a0, a1; unpack8(*(const u32x4*)(ADD + off + bj * HALF), a0, a1); v0 = v0 + a0; v1 = v1 + a1; }
                    *(u32x4*)(O + off + bj * HALF) = pack8(v0, v1); } }
    }
};
struct EpiOutFast {
    static constexpr bool PERM = false, AFTER_DRAIN = false;
    const float* x; const float* mod; float* y;
    __device__ __forceinline__ void operator()(const f32x4 (&acc)[2][2][4][2], const Unit& u, int wr, int wc, int fr, int fq) const {
        const int row0 = u.pm * BM + wr * 64 + fr, col0 = u.pn * BM + wc * 32 + 4 * fq;
        const float* gate = mod + (size_t)(u.pm >> 5) * 3072 + 2048;
        f32x4 gv[2][2];
#pragma unroll
        for (int bj = 0; bj < 2; ++bj)
#pragma unroll
            for (int n = 0; n < 2; ++n) gv[bj][n] = *(const f32x4*)(gate + col0 + bj * HALF + n * 16);
#pragma unroll
        for (int ai = 0; ai < 2; ++ai)
#pragma unroll
            for (int m = 0; m < 4; ++m) { const size_t off = (size_t)(row0 + ai * HALF + m * 16) * D + col0;
#pragma unroll
                for (int bj = 0; bj < 2; ++bj)
#pragma unroll
                    for (int n = 0; n < 2; ++n) { const f32x4 xv = *(const f32x4*)(x + off + bj * HALF + n * 16);
                        *(f32x4*)(y + off + bj * HALF + n * 16) = xv * ALPHA + gv[bj][n] * acc[ai][bj][m][n]; } }
    }
};

template <class Epi, class Sched, bool ALIGN_EPI = false, bool SP2 = false>
__device__ __forceinline__ void gemm_phase(PG8_LAS unsigned char* lds, const Gemm g, const Sched& S, const Epi& E) {
    const int tid = threadIdx.x, wid = __builtin_amdgcn_readfirstlane(tid >> 6), lane = tid & 63, wr = wid >> 2, wc = wid & 3, fr = lane & 15, fq = lane >> 4;
    const int K = g.K, nt = K / BK;
    unsigned voffA[2], voffB[2];
#pragma unroll
    for (int i = 0; i < 2; ++i) { int R, C; stage_rc(tid * 16 + i * 8192, R, C); const int Rb = Epi::PERM ? ((R & ~31) + perm32(R & 31)) : R;
        voffA[i] = (unsigned)(R * K + C) * 2u; voffB[i] = (unsigned)(Rb * K + C) * 2u; }
    const size_t kstep = (size_t)(BK * 2);
    const size_t hstep = (size_t)HALF * K * 2;
    const size_t tstep = 2 * hstep;
    const unsigned ldsw = (unsigned)wid * 1024u;
    const int aoff = lds_byte(wr * 64 + fr, fq * 8), boff = lds_byte(wc * 32 + fr, fq * 8);
#define PG8_SA(b, h) (((b) * 2 + (h)) * HTB)
#define PG8_SB(b, h) ((4 + (b) * 2 + (h)) * HTB)
#define PG8_STAGE(bufoff, gbase, voff) do { _Pragma("unroll") for (int _i = 0; _i < 2; ++_i) \
        __builtin_amdgcn_global_load_lds((const unsigned*)((const char*)(gbase) + (voff)[_i]), (PG8_LAS unsigned*)(lds + (bufoff) + ldsw + _i * 8192), 16, 0, 0); } while (0)
#define PG8_LDA(dst, b, h) do { _Pragma("unroll") for (int m = 0; m < 4; ++m) _Pragma("unroll") for (int k = 0; k < 2; ++k) dst[m][k] = *(const PG8_LAS bf16x8*)(lds + PG8_SA(b, h) + aoff + m * 2048 + k * 1024); } while (0)
#define PG8_LDB(dst, b, h) do { _Pragma("unroll") for (int n = 0; n < 2; ++n) _Pragma("unroll") for (int k = 0; k < 2; ++k) dst[n][k] = *(const PG8_LAS bf16x8*)(lds + PG8_SB(b, h) + boff + n * 2048 + k * 1024); } while (0)
#define PG8_MMA(ai, bj, At, Bt) do { __builtin_amdgcn_s_setprio(1); _Pragma("unroll") for (int m = 0; m < 4; ++m) _Pragma("unroll") for (int n = 0; n < 2; ++n) _Pragma("unroll") for (int k = 0; k < 2; ++k) \
        acc[ai][bj][m][n] = __builtin_amdgcn_mfma_f32_16x16x32_bf16(Bt[n][k], At[m][k], acc[ai][bj][m][n], 0, 0, 0); __builtin_amdgcn_s_setprio(0); } while (0)
#define PG8_WAIT_V(n) asm volatile("s_waitcnt vmcnt(" #n ")" ::: "memory")
#define PG8_WAIT_L(n) asm volatile("s_waitcnt lgkmcnt(" #n ")" ::: "memory")
#define PG8_BAR __builtin_amdgcn_s_barrier()
#define PG8_SCHED __builtin_amdgcn_sched_barrier(0)
    Unit cur, nxt; int ui = 0;
    if (!S.next(0, cur)) return;
    f32x4 acc[2][2][4][2];
#pragma unroll
    for (int a = 0; a < 2; ++a)
#pragma unroll
        for (int b = 0; b < 2; ++b)
#pragma unroll
            for (int m = 0; m < 4; ++m)
#pragma unroll
                for (int n = 0; n < 2; ++n) acc[a][b][m][n] = (f32x4){0.f, 0.f, 0.f, 0.f};
    bf16x8 At[4][2], B0[2][2], B1[2][2];
    const char* cA = (const char*)g.A + (size_t)cur.pm * tstep; const char* cB = (const char*)g.Bt + (size_t)cur.pn * tstep;
    S.a_ready(cur);
    if constexpr (SP2) {
        PG8_STAGE(PG8_SB(0, 0), cB, voffB); PG8_STAGE(PG8_SB(0, 1), cB + hstep, voffB); PG8_STAGE(PG8_SA(0, 0), cA, voffA); PG8_STAGE(PG8_SA(0, 1), cA + hstep, voffA);
        if (wr == 1) PG8_BAR;
        PG8_WAIT_V(2); PG8_BAR;
        PG8_STAGE(PG8_SB(1, 0), cB + kstep, voffB); PG8_STAGE(PG8_SA(1, 0), cA + kstep, voffA); PG8_STAGE(PG8_SB(1, 1), cB + hstep + kstep, voffB);
        PG8_WAIT_V(6); PG8_BAR;
    } else {
        PG8_STAGE(PG8_SB(0, 0), cB, voffB); PG8_STAGE(PG8_SA(0, 0), cA, voffA); PG8_STAGE(PG8_SB(0, 1), cB + hstep, voffB); PG8_STAGE(PG8_SA(0, 1), cA + hstep, voffA);
        if (wr == 1) PG8_BAR;
        PG8_WAIT_V(4); PG8_BAR;
        PG8_STAGE(PG8_SB(1, 0), cB + kstep, voffB); PG8_STAGE(PG8_SA(1, 0), cA + kstep, voffA); PG8_STAGE(PG8_SB(1, 1), cB + hstep + kstep, voffB);
        PG8_WAIT_V(6); PG8_BAR;
    }
    for (;;) {
        const bool has_next = S.next(ui + 1, nxt);
        const char* nA = has_next ? (const char*)g.A + (size_t)nxt.pm * tstep : cA; const char* nB = has_next ? (const char*)g.Bt + (size_t)nxt.pn * tstep : cB;
        for (int t = 0; t < nt; t += 2) {
            const bool last = (t == nt - 2);
            const char* a1 = cA + (size_t)(t + 1) * kstep;
            const char* a2 = last ? nA : cA + (size_t)(t + 2) * kstep; const char* b2 = last ? nB : cB + (size_t)(t + 2) * kstep;
            const char* a3 = a2 + kstep; const char* b3 = b2 + kstep;
            if (last && has_next) S.a_ready(nxt);
            if constexpr (SP2) {
            PG8_LDB(B0, 0, 0); PG8_LDB(B1, 0, 1); PG8_SCHED; PG8_LDA(At, 0, 0); PG8_STAGE(PG8_SA(1, 1), a1 + hstep, voffA);
            PG8_WAIT_V(8); PG8_WAIT_L(0); PG8_BAR; PG8_MMA(0, 0, At, B0); PG8_MMA(0, 1, At, B1); PG8_BAR; PG8_SCHED;
            PG8_LDA(At, 0, 1); PG8_STAGE(PG8_SB(0, 0), b2, voffB); PG8_STAGE(PG8_SB(0, 1), b2 + hstep, voffB); PG8_STAGE(PG8_SA(0, 0), a2, voffA);
            PG8_WAIT_V(8); PG8_WAIT_L(0); PG8_BAR; PG8_MMA(1, 0, At, B0); PG8_MMA(1, 1, At, B1); PG8_BAR; PG8_SCHED;
            PG8_LDB(B0, 1, 0); PG8_LDB(B1, 1, 1); PG8_SCHED; PG8_LDA(At, 1, 0); PG8_STAGE(PG8_SA(0, 1), a2 + hstep, voffA);
            PG8_WAIT_V(8); PG8_WAIT_L(0); PG8_BAR; PG8_MMA(0, 0, At, B0); PG8_MMA(0, 1, At, B1); PG8_BAR; PG8_SCHED;
            PG8_LDA(At, 1, 1); PG8_STAGE(PG8_SB(1, 0), b3, voffB); PG8_STAGE(PG8_SB(1, 1), b3 + hstep, voffB); PG8_STAGE(PG8_SA(1, 0), a3, voffA);
            PG8_WAIT_V(8); PG8_WAIT_L(0); PG8_BAR; PG8_MMA(1, 0, At, B0); PG8_MMA(1, 1, At, B1); PG8_BAR; PG8_SCHED;
            } else {
            PG8_LDB(B0, 0, 0); PG8_SCHED; PG8_LDA(At, 0, 0); PG8_STAGE(PG8_SA(1, 1), a1 + hstep, voffA);
            PG8_WAIT_L(8); PG8_BAR; PG8_WAIT_L(0); PG8_MMA(0, 0, At, B0); PG8_BAR; PG8_SCHED;
            PG8_LDB(B1, 0, 1); PG8_STAGE(PG8_SB(0, 0), b2, voffB);
            PG8_BAR; PG8_WAIT_L(0); PG8_MMA(0, 1, At, B1); PG8_BAR;
            PG8_LDA(At, 0, 1); PG8_STAGE(PG8_SA(0, 0), a2, voffA);
            PG8_BAR; PG8_WAIT_L(0); PG8_MMA(1, 0, At, B0); PG8_BAR; PG8_SCHED;
            PG8_STAGE(PG8_SB(0, 1), b2 + hstep, voffB);
            PG8_WAIT_V(6); PG8_BAR; PG8_MMA(1, 1, At, B1); PG8_BAR;
            PG8_LDB(B0, 1, 0); PG8_SCHED; PG8_LDA(At, 1, 0); PG8_STAGE(PG8_SA(0, 1), a2 + hstep, voffA);
            PG8_WAIT_L(8); PG8_BAR; PG8_WAIT_L(0); PG8_MMA(0, 0, At, B0); PG8_BAR; PG8_SCHED;
            PG8_LDB(B1, 1, 1); PG8_STAGE(PG8_SB(1, 0), b3, voffB);
            PG8_BAR; PG8_WAIT_L(0); PG8_MMA(0, 1, At, B1); PG8_BAR;
            PG8_LDA(At, 1, 1); PG8_STAGE(PG8_SA(1, 0), a3, voffA);
            PG8_BAR; PG8_WAIT_L(0); PG8_MMA(1, 0, At, B0); PG8_BAR; PG8_SCHED;
            PG8_STAGE(PG8_SB(1, 1), b3 + hstep, voffB);
            PG8_WAIT_V(6); PG8_BAR; PG8_MMA(1, 1, At, B1); PG8_BAR;
            }
        }
        if constexpr (ALIGN_EPI) { if (wr == 0) PG8_BAR; }
        if constexpr (!Epi::AFTER_DRAIN) { E(acc, cur, wr, wc, fr, fq); S.done(cur); }
        if (!has_next) break;
#pragma unroll
        for (int a = 0; a < 2; ++a)
#pragma unroll
            for (int b = 0; b < 2; ++b)
#pragma unroll
                for (int m = 0; m < 4; ++m)
#pragma unroll
                    for (int n = 0; n < 2; ++n) acc[a][b][m][n] = (f32x4){0.f, 0.f, 0.f, 0.f};
        cur = nxt; cA = nA; cB = nB; ++ui;
        if constexpr (ALIGN_EPI) { if (wr == 1) PG8_BAR; }
    }
    PG8_WAIT_V(0);
    if constexpr (!ALIGN_EPI) { if (wr == 0) PG8_BAR; }
    PG8_BAR;
    if constexpr (Epi::AFTER_DRAIN) { E.fused(acc, cur, wr, wc, fr, fq, lds, wid, lane); S.done(cur); }
#undef PG8_SA
#undef PG8_SB
#undef PG8_STAGE
#undef PG8_LDA
#undef PG8_LDB
#undef PG8_MMA
#undef PG8_WAIT_V
#undef PG8_WAIT_L
#undef PG8_BAR
#undef PG8_SCHED
}
}
#define GAS __attribute__((address_space(1)))
#define LAS __attribute__((address_space(3)))
typedef unsigned v4u __attribute__((ext_vector_type(4)));
typedef float f32x4 __attribute__((ext_vector_type(4)));
typedef short bf16x8 __attribute__((ext_vector_type(8)));
typedef GAS unsigned gu32;
#define RLX_AGENT __ATOMIC_RELAXED, __HIP_MEMORY_SCOPE_AGENT
#define LDS_WAIT() asm volatile("s_waitcnt lgkmcnt(0)" ::: "memory")
#define VM_WAIT() asm volatile("s_waitcnt vmcnt(0)" ::: "memory")
#define XB_TMO      128
#define XB_XCNT(j)  (256  + 64 * (j))
#define XB_XSUB(j)  (1280 + 64 * (j))
#define XB_XGEN(j)  (2304 + 64 * (j))
#define XB_TOP      3328
#define XB_TOPGEN   3392
#define XCD_BAR_WORDS 3456
#define XB_SPIN_CAP (1u << 18)

__device__ __forceinline__ unsigned xb_ld(unsigned* p)              { return __hip_atomic_load(p, __ATOMIC_RELAXED, __HIP_MEMORY_SCOPE_AGENT); }
__device__ __forceinline__ unsigned xb_add(unsigned* p, unsigned v) { return __hip_atomic_fetch_add(p, v, __ATOMIC_RELAXED, __HIP_MEMORY_SCOPE_AGENT); }
__device__ __forceinline__ unsigned xb_xcc_id() { return (unsigned)__builtin_amdgcn_s_getreg((3 << 11) | 20) & 0xFu; }
#define XB_SPIN(cond, bar) do { unsigned _sp = 0; while (cond) { __builtin_amdgcn_s_sleep(1); \
    if ((++_sp & 255u) == 0u) { if (xb_ld(&(bar)[XB_TMO])) break; if (_sp > XB_SPIN_CAP) { atomicAdd(&(bar)[XB_TMO], 1u); break; } } } } while (0)

struct XcdBarrier {
    unsigned* bar; unsigned x;
    volatile LAS unsigned* st;
};

__device__ __forceinline__ XcdBarrier xcd_barrier_post(unsigned* bar, volatile LAS unsigned* st) {
    XcdBarrier b; b.bar = bar; b.x = xb_xcc_id(); b.st = st;
    if (threadIdx.x == 0) (void)xb_add(&bar[XB_XCNT(b.x)], 1u);
    return b;
}
__device__ __forceinline__ void xcd_barrier_complete(unsigned* bar, unsigned x, unsigned& nloc, unsigned& nx) {
    const unsigned G = gridDim.x * gridDim.y * gridDim.z;
    unsigned sum, cnt, mine, sp = 0u;
    for (;;) {
        sum = 0u; cnt = 0u; mine = 0u;
#pragma unroll
        for (unsigned j = 0; j < 16; ++j) { const unsigned c = xb_ld(&bar[XB_XCNT(j)]); sum += c; cnt += (c > 0u) ? 1u : 0u; mine = (j == x) ? c : mine; }
        if (sum == G) break;
        __builtin_amdgcn_s_sleep(1);
        if ((++sp & 255u) == 0u) { if (xb_ld(&bar[XB_TMO])) break; if (sp > XB_SPIN_CAP) { atomicAdd(&bar[XB_TMO], 1u); break; } }
    }
    nloc = mine > 0u ? mine : 1u; nx = cnt > 0u ? cnt : 1u;
}

__device__ __forceinline__ void xcd_barrier(const XcdBarrier& b) {
    asm volatile("s_waitcnt vmcnt(0)" ::: "memory");
    __syncthreads();
    if (threadIdx.x == 0) {
        unsigned* bar = b.bar;
        __builtin_amdgcn_s_waitcnt(0);
        unsigned nloc = b.st[0], nx = b.st[1];
        if (nloc == 0u) { xcd_barrier_complete(bar, b.x, nloc, nx); b.st[0] = nloc; b.st[1] = nx; }
        const unsigned old = xb_add(&bar[XB_XSUB(b.x)], 1u);
        const unsigned gen = old / nloc;
        if (old + 1u == (gen + 1u) * nloc) {
            __builtin_amdgcn_fence(__ATOMIC_RELEASE, "agent");
            asm volatile("s_waitcnt vmcnt(0)" ::: "memory");
            const unsigned og = xb_add(&bar[XB_TOP], 1u);
            const unsigned tg = og / nx;
            if (og + 1u == (tg + 1u) * nx) xb_add(&bar[XB_TOPGEN], 1u);
            else XB_SPIN(xb_ld(&bar[XB_TOPGEN]) == tg, bar);
            __builtin_amdgcn_fence(__ATOMIC_ACQUIRE, "agent");
            xb_add(&bar[XB_XGEN(b.x)], 1u);
            asm volatile("s_waitcnt vmcnt(0)" ::: "memory");
        } else {
            XB_SPIN(xb_ld(&bar[XB_XGEN(b.x)]) == gen, bar);
            __builtin_amdgcn_fence(__ATOMIC_ACQUIRE, "agent");
            asm volatile("s_waitcnt vmcnt(0)" ::: "memory");
        }
    }
    __syncthreads();
}

constexpr int NWAVES = 8;
constexpr int RING_OFF = 0, RING_BYTES = 131072;
constexpr int LDSCTL_OFF = RING_BYTES, MISC_OFF = LDSCTL_OFF + 320;
constexpr int LDS_BYTES = 147456;
constexpr int CW_BAR = 4096;
constexpr size_t CTL_ZERO_BYTES = 256 * 1024;

struct Args { P p; int ph_lo, ph_hi, li, pad; };

__global__ void __launch_bounds__(NWAVES * 64, 2) mega(Args a) {
    extern __shared__ __attribute__((aligned(16))) unsigned char lds[];
    const P& p = a.p;
    LAS unsigned char* L = (LAS unsigned char*)lds;
    volatile LAS unsigned* MISC = (volatile LAS unsigned*)(L + MISC_OFF);
    const int tid = threadIdx.x;
    for (int u = tid; u < (LDS_BYTES - LDSCTL_OFF) / 4; u += NWAVES * 64) ((LAS unsigned*)(L + LDSCTL_OFF))[u] = 0u;
    __syncthreads();
    XcdBarrier bar = xcd_barrier_post((unsigned*)(p.ws + WS_CTL) + CW_BAR + a.li * XCD_BAR_WORDS, MISC + 8);
    const int lo = a.ph_lo, hi = a.ph_hi, G = gridDim.x;
#define IN(k) (lo <= (k) && (k) < hi)
#define BOTH(k) (IN(k) && IN((k) + 1))

    if (IN(2)) {
        pg8::Gemm g{p.rp.H, p.win, MP, DIN, D}; pg8::StaticOrder S; S.init(MP, DIN, G, (int)blockIdx.x);
        pg8::EpiInprojFast E{p.rp.US, p.rp.SZS, p.rp.Q, p.rp.SZA, p.rp.SGS, p.rp.SGA, p.K, p.VT, p.out};
        pg8::gemm_phase<pg8::EpiInprojFast, pg8::StaticOrder, true, true>(L + RING_OFF, g, S, E);
        if (BOTH(2)) xcd_barrier(bar);
    }
    if (IN(5)) {
        { pg8::Gemm g{p.rp.YG, p.wglu, MP, D, D}; pg8::StaticOrder S; S.init(MP, D, G, (int)blockIdx.x);
          pg8::EpiGluFast E{p.rp.YG, p.rp.SZS, p.rp.V, p.in[20]};
          pg8::gemm_phase<pg8::EpiGluFast, pg8::StaticOrder, true, true>(L + RING_OFF, g, S, E); }
        { pg8::Gemm g{p.rp.Q, p.wba, MP, D, D}; pg8::StaticOrder S; S.init(MP, D, G, (int)blockIdx.x);
          pg8::EpiGateFast<false> E{p.rp.SGA, nullptr, p.rp.T1};
          pg8::gemm_phase<pg8::EpiGateFast<false>, pg8::StaticOrder, true, true>(L + RING_OFF, g, S, E); }
        if (BOTH(5)) xcd_barrier(bar);
    }
    if (IN(6)) {
        pg8::Gemm g{p.rp.V, p.wbs, MP, D, D}; pg8::StaticOrder S; S.init(MP, D, G, (int)blockIdx.x);
        pg8::EpiGateFast<true> E{p.rp.SGS, p.rp.T1, p.rp.MM};
        pg8::gemm_phase<pg8::EpiGateFast<true>, pg8::StaticOrder, true, true>(L + RING_OFF, g, S, E);
        if (BOTH(6)) xcd_barrier(bar);
    }
    if (IN(7)) {
        pg8::Gemm g{p.rp.MM, p.wout, MP, D, D}; pg8::StaticOrder S; S.init(MP, D, G, (int)blockIdx.x);
        pg8::EpiOutFast E{p.rp.x, p.mod, p.rp.y};
        pg8::gemm_phase<pg8::EpiOutFast, pg8::StaticOrder, true, true>(L + RING_OFF, g, S, E);
        if (BOTH(7)) xcd_barrier(bar);
    }
#undef IN
#undef BOTH
}

__global__ void k_mod(P p) {
    const int idx = blockIdx.x * blockDim.x + threadIdx.x;
    if (idx >= 130 * 3072) return;
    const int r = idx / 3072, n = idx % 3072;
    const float* c = r < 2 ? p.in[2] + (size_t)r * D : p.in[3] + (size_t)(r - 2) * D;
    const float* w = p.in[8];
    float acc = p.in[9][n];
    for (int k = 0; k < D; ++k) acc += siluf_(c[k]) * w[(size_t)k * 3072 + n];
    p.mod[idx] = acc;
}
__global__ void k_tables(P p) {
    const int idx = blockIdx.x * blockDim.x + threadIdx.x;
    if (idx < NG * NP) {
        const int g = idx / NP;
        const double lr = p.in[11][idx], li = p.in[12][idx], dt = exp((double)p.in[13][g]);
        const double mag = exp(lr * dt), ar = mag * cos(li * dt), ai = mag * sin(li * dt);
        const double den = lr * lr + li * li, nr = ar - 1.0, cr = (nr * lr + ai * li) / den, ci = (ai * lr - nr * li) / den;
        p.ar[idx] = (float)ar; p.ai[idx] = (float)ai;
        double pr = ar, pi = ai;
        for (int s = 0; s < 7; ++s) { const double nr2 = pr * pr - pi * pi, ni2 = 2.0 * pr * pi; pr = nr2; pi = ni2; }
        p.atr[idx] = (float)pr; p.ati[idx] = (float)pi;
        const int pp = idx % NP;
        for (int c = 0; c < GC; ++c) {
            const double br = p.in[14][(size_t)idx * GC + c], bi = p.in[15][(size_t)idx * GC + c];
            const float bbr = (float)(cr * br - ci * bi), bbi = (float)(cr * bi + ci * br);
            p.bbf[((size_t)(g * 2 + 0) * NP + pp) * GC + c] = bbr; p.bbf[((size_t)(g * 2 + 1) * NP + pp) * GC + c] = bbi;
            p.bb[((size_t)(g * 2 + 0) * NP + pp) * GC + c] = f2bf(bbr); p.bb[((size_t)(g * 2 + 1) * NP + pp) * GC + c] = f2bf(bbi);
            p.cmt[((size_t)g * GC + c) * 128 + 2 * pp + 0] = f2bf(p.in[16][((size_t)g * GC + c) * NP + pp]);
            p.cmt[((size_t)g * GC + c) * 128 + 2 * pp + 1] = f2bf(-p.in[17][((size_t)g * GC + c) * NP + pp]);
        }
    }
    if (idx < NH * 132) {
        const int h = idx / 132, d = idx % 132;
        float v = 0.f;
        if (d <= 128) {
            int bucket;
            if (d < 16) bucket = d;
            else { const float df = (float)d; int large = 16 + (int)(logf(df / 16.f) / logf(8.f) * 16.f); bucket = large < 31 ? large : 31; }
            v = p.in[22][bucket * NH + h] * LOG2E;
        }
        p.biasl[idx] = v;
    }
    if (idx < NH) p.biasl[NH * 132 + idx] = p.in[21][idx] * LOG2E;
}
__global__ void k_transpose(const float* W, bf16_t* WT, int K, int N) {
    const size_t idx = (size_t)blockIdx.x * blockDim.x + threadIdx.x;
    if (idx >= (size_t)K * N) return;
    const int n = (int)(idx / K), k = (int)(idx % K);
    WT[idx] = f2bf(W[(size_t)k * N + n]);
}
__global__ void k_h(P p, Rows r) {
    const size_t idx = (size_t)blockIdx.x * blockDim.x + threadIdx.x;
    if (idx >= (size_t)r.M * D) return;
    const int row = (int)(idx / D), k = (int)(idx % D);
    const float* m = p.mod + (size_t)modrow(r, row) * 3072;
    r.H[idx] = f2bf(r.x[idx] * (1.f + m[1024 + k]) + m[k]);
}
struct EpiInproj {
    P pp; int sample, pad;
    __device__ void operator()(int row, int col, float v) const {
        const P* p = &pp; const Rows& R = sample ? pp.rs : pp.rp;
        if (col < 1024) R.US[(size_t)row * D + col] = f2bf(v);
        else if (col < 2048) R.SZS[(size_t)row * D + col - 1024] = f2bf(siluf_(v));
        else if (col < 3072) R.Q[(size_t)row * D + col - 2048] = f2bf(v * QSCALE);
        else if (col < 3328) {
            const int c = col - 3072;
            if (R.is_sample) p->out[OS_K + ((size_t)row * WIN + 127) * KVW + c] = v;
            else { p->K[(size_t)row * KVW + c] = f2bf(v); const int b = row / SEQ, t = row % SEQ; if (t >= SEQ - WIN) p->out[OP_K + ((size_t)b * WIN + t - (SEQ - WIN)) * KVW + c] = v; }
        } else if (col < 3584) {
            const int c = col - 3328;
            if (R.is_sample) p->out[OS_V + ((size_t)row * WIN + 127) * KVW + c] = v;
            else { const int b = row / SEQ, t = row % SEQ; p->VT[((size_t)(b * NKV + (c >> 6)) * HD + (c & 63)) * SEQ + t] = f2bf(v); if (t >= SEQ - WIN) p->out[OP_V + ((size_t)b * WIN + t - (SEQ - WIN)) * KVW + c] = v; }
        } else if (col < 4608) R.SZA[(size_t)row * D + col - 3584] = f2bf(siluf_(v));
        else if (col < 5632) R.SGS[(size_t)row * D + col - 4608] = f2bf(sigmoidf_(v));
        else R.SGA[(size_t)row * D + col - 5632] = f2bf(sigmoidf_(v));
    }
};
struct EpiGlu {
    const float* bglu; Rows rr;
    __device__ void operator()(int row, int col, float v) const {
        const Rows* r = &rr; const size_t i = (size_t)row * D + col;
        r->V[i] = f2bf(bf2f(r->YG[i]) * sigmoidf_(v + bglu[col]) * bf2f(r->SZS[i]));
    }
};
struct EpiBa {
    Rows rr;
    __device__ void operator()(int row, int col, float v) const { const Rows* r = &rr; const size_t i = (size_t)row * D + col; r->T1[i] = f2bf(bf2f(r->SGA[i]) * v); }
};
struct EpiBs {
    Rows rr;
    __device__ void operator()(int row, int col, float v) const { const Rows* r = &rr; const size_t i = (size_t)row * D + col; r->MM[i] = f2bf(bf2f(r->SGS[i]) * v + bf2f(r->T1[i])); }
};
struct EpiOut {
    const float* mod; Rows rr;
    __device__ void operator()(int row, int col, float v) const {
        const Rows* r = &rr; const size_t i = (size_t)row * D + col;
        r->y[i] = ALPHA * r->x[i] + mod[(size_t)modrow(*r, row) * 3072 + 2048 + col] * v;
    }
};
template <class Epi>
__global__ void k_gemm_naive(const bf16_t* A, const bf16_t* Bt, int M, int N, int K, int pad, Epi epi) {
    const size_t idx = (size_t)blockIdx.x * blockDim.x + threadIdx.x;
    if (idx >= (size_t)M * N) return;
    const int row = (int)(idx / N), col = (int)(idx % N);
    const uint4* a = (const uint4*)(A + (size_t)row * K); const uint4* b = (const uint4*)(Bt + (size_t)col * K);
    float acc = 0.f;
    for (int k = 0; k < K / 8; ++k) {
        const uint4 av = a[k], bv = b[k];
        const unsigned aw[4] = {av.x, av.y, av.z, av.w}, bw[4] = {bv.x, bv.y, bv.z, bv.w};
#pragma unroll
        for (int j = 0; j < 4; ++j) { acc += __uint_as_float(aw[j] << 16) * __uint_as_float(bw[j] << 16); acc += __uint_as_float(aw[j] & 0xffff0000u) * __uint_as_float(bw[j] & 0xffff0000u); }
    }
    epi(row, col, acc);
}
__global__ void __launch_bounds__(64) k_ssm_naive(P p, Rows r, int T, int pad) {
    const int lane = threadIdx.x, g = blockIdx.x % NG, b = blockIdx.x / NG;
    const int gp = g * NP + lane;
    const float ar = p.ar[gp], ai = p.ai[gp];
    float bbr[GC], bbi[GC], cre[GC], cim[GC];
#pragma unroll
    for (int c = 0; c < GC; ++c) {
        bbr[c] = p.bbf[((size_t)(g * 2 + 0) * NP + lane) * GC + c]; bbi[c] = p.bbf[((size_t)(g * 2 + 1) * NP + lane) * GC + c];
        cre[c] = p.in[16][((size_t)g * GC + c) * NP + lane]; cim[c] = p.in[17][((size_t)g * GC + c) * NP + lane];
    }
    float hr = 0.f, hi = 0.f;
    if (r.is_sample) { hr = p.in[4][((size_t)b * NG + g) * NP + lane]; hi = p.in[5][((size_t)b * NG + g) * NP + lane]; }
    const float dsk = p.in[18][g * GC + (lane & 15)];
    for (int t = 0; t < T; ++t) {
        const size_t row = (size_t)b * T + t;
        const bf16_t* u = r.US + row * D + g * GC;
        float xr = 0.f, xi = 0.f, uu[GC];
#pragma unroll
        for (int c = 0; c < GC; ++c) { uu[c] = bf2f(u[c]); xr += bbr[c] * uu[c]; xi += bbi[c] * uu[c]; }
        const float nhr = ar * hr - ai * hi + xr, nhi = ar * hi + ai * hr + xi; hr = nhr; hi = nhi;
        float mine = 0.f, myu = 0.f;
#pragma unroll
        for (int c = 0; c < GC; ++c) {
            float v = cre[c] * hr - cim[c] * hi;
#pragma unroll
            for (int o = 1; o < 64; o <<= 1) v += __shfl_xor(v, o);
            if ((lane & 15) == c) { mine = v; myu = uu[c]; }
        }
        if (lane < GC) r.YG[row * D + g * GC + lane] = f2bf(gelu_tanh(mine + dsk * myu));
    }
    float* ohr = p.out + (r.is_sample ? OS_HR : OP_HR); float* ohi = p.out + (r.is_sample ? OS_HI : OP_HI);
    ohr[((size_t)b * NG + g) * NP + lane] = hr; ohi[((size_t)b * NG + g) * NP + lane] = hi;
}
__global__ void __launch_bounds__(64) k_attn_naive(P p) {
    const int idx = blockIdx.x * blockDim.x + threadIdx.x;
    if (idx >= NH * MP) return;
    const int head = idx / MP, row = idx % MP, b = row / SEQ, t = row % SEQ, kvh = head >> 2;
    const Rows& R = p.rp;
    float q[HD], o[HD];
#pragma unroll
    for (int d = 0; d < HD; ++d) { q[d] = bf2f(R.Q[(size_t)row * D + head * HD + d]); o[d] = 0.f; }
    const float sink = p.biasl[NH * 132 + head];
    float m = sink, l = 1.f;
    const int k0 = t - WIN < 0 ? 0 : t - WIN;
    for (int kp = k0; kp <= t; ++kp) {
        const bf16_t* kr = p.K + (size_t)(b * SEQ + kp) * KVW + kvh * HD;
        float s = 0.f;
#pragma unroll
        for (int d = 0; d < HD; ++d) s += q[d] * bf2f(kr[d]);
        s += p.biasl[head * 132 + (t - kp)];
        const float mn = fmaxf(m, s), f = exp2f(m - mn), pe = exp2f(s - mn);
        l = l * f + pe; m = mn;
        const bf16_t* vt = p.VT + ((size_t)(b * NKV + kvh) * HD) * SEQ + kp;
#pragma unroll
        for (int d = 0; d < HD; ++d) o[d] = o[d] * f + pe * bf2f(vt[(size_t)d * SEQ]);
    }
    const float inv = 1.f / l;
#pragma unroll
    for (int d = 0; d < HD; ++d) { const size_t i = (size_t)row * D + head * HD + d; R.Q[i] = f2bf(o[d] * inv * bf2f(R.SZA[i])); }
}
__global__ void k_cache_shift(P p) {
    const size_t idx = (size_t)blockIdx.x * blockDim.x + threadIdx.x;
    if (idx >= (size_t)MS * 127 * KVW) return;
    const int b = (int)(idx / (127 * KVW)), rem = (int)(idx % (127 * KVW));
    p.out[OS_K + (size_t)b * WIN * KVW + rem] = p.in[6][(size_t)b * WIN * KVW + KVW + rem];
    p.out[OS_V + (size_t)b * WIN * KVW + rem] = p.in[7][(size_t)b * WIN * KVW + KVW + rem];
}
__global__ void __launch_bounds__(64) k_attn_sample_naive(P p) {
    const int idx = blockIdx.x * blockDim.x + threadIdx.x;
    if (idx >= MS * NH) return;
    const int b = idx / NH, head = idx % NH, kvh = head >> 2;
    const Rows& R = p.rs;
    float q[HD], o[HD];
#pragma unroll
    for (int d = 0; d < HD; ++d) { q[d] = bf2f(R.Q[(size_t)b * D + head * HD + d]); o[d] = 0.f; }
    const float sink = p.biasl[NH * 132 + head];
    float m = sink, l = 1.f;
    for (int j = 0; j <= WIN; ++j) {
        const float* kr = j < WIN ? p.in[6] + ((size_t)b * WIN + j) * KVW + kvh * HD : p.out + OS_K + ((size_t)b * WIN + 127) * KVW + kvh * HD;
        const float* vr = j < WIN ? p.in[7] + ((size_t)b * WIN + j) * KVW + kvh * HD : p.out + OS_V + ((size_t)b * WIN + 127) * KVW + kvh * HD;
        float s = 0.f;
#pragma unroll
        for (int d = 0; d < HD; ++d) s += q[d] * kr[d];
        s += p.biasl[head * 132 + (WIN - j)];
        const float mn = fmaxf(m, s), f = exp2f(m - mn), pe = exp2f(s - mn);
        l = l * f + pe; m = mn;
#pragma unroll
        for (int d = 0; d < HD; ++d) o[d] = o[d] * f + pe * vr[d];
    }
    const float inv = 1.f / l;
#pragma unroll
    for (int d = 0; d < HD; ++d) { const size_t i = (size_t)b * D + head * HD + d; R.Q[i] = f2bf(o[d] * inv * bf2f(R.SZA[i])); }
}
__global__ void k_ln(P p, Rows r) {
    const int lane = threadIdx.x & 63, row = blockIdx.x * (blockDim.x / 64) + (threadIdx.x >> 6);
    if (row >= r.M) return;
    float* y = r.y + (size_t)row * D;
    float v[16], s = 0.f;
#pragma unroll
    for (int j = 0; j < 16; ++j) { v[j] = y[lane + 64 * j]; s += v[j]; }
#pragma unroll
    for (int o = 1; o < 64; o <<= 1) s += __shfl_xor(s, o);
    const float mean = s * (1.f / D); float q = 0.f;
#pragma unroll
    for (int j = 0; j < 16; ++j) { v[j] -= mean; q += v[j] * v[j]; }
#pragma unroll
    for (int o = 1; o < 64; o <<= 1) q += __shfl_xor(q, o);
    const float rstd = 1.f / sqrtf(q * (1.f / D) + LN_EPS);
#pragma unroll
    for (int j = 0; j < 16; ++j) { const int c = lane + 64 * j; y[c] = v[j] * rstd * p.in[26][c] + p.in[27][c]; }
}

static void fill_params(P& p, void* const* d_in, void* d_out, void* d_ws) {
    for (int i = 0; i < 28; ++i) p.in[i] = (const float*)d_in[i];
    p.out = (float*)d_out; p.ws = (unsigned char*)d_ws;
    unsigned char* ws = p.ws;
    p.mod = (float*)(ws + WS_MOD);
    p.ar = (float*)(ws + WS_AR); p.ai = p.ar + 4096; p.atr = p.ar + 8192; p.ati = p.ar + 12288;
    p.bbf = (float*)(ws + WS_BBF); p.bb = (bf16_t*)(ws + WS_BB); p.cmt = (bf16_t*)(ws + WS_CMT); p.biasl = (float*)(ws + WS_BIAS);
    p.win = (bf16_t*)(ws + WS_WIN); p.wglu = (bf16_t*)(ws + WS_WGLU); p.wbs = (bf16_t*)(ws + WS_WBS); p.wba = (bf16_t*)(ws + WS_WBA); p.wout = (bf16_t*)(ws + WS_WOUT);
    p.E = (float*)(ws + WS_E); p.K = (bf16_t*)(ws + WS_K); p.VT = (bf16_t*)(ws + WS_VT);
    Rows& a = p.rp; a.M = MP; a.is_sample = 0; a.x = p.in[0];
    a.H = (bf16_t*)d_out;
    a.YG = (bf16_t*)d_out;
    a.US = (bf16_t*)(ws + WS_US); a.SZS = (bf16_t*)(ws + WS_SZS); a.Q = (bf16_t*)(ws + WS_Q); a.SZA = (bf16_t*)(ws + WS_SZA);
    a.SGS = (bf16_t*)(ws + WS_SGS); a.SGA = (bf16_t*)(ws + WS_SGA);
    a.V = a.US; a.T1 = a.SZA; a.MM = a.SZS; a.y = p.out + OY_P;
    Rows& s = p.rs; s.M = MS; s.is_sample = 1; s.x = p.in[1];
    bf16_t* sb = (bf16_t*)(ws + WS_SAMPLE); const size_t SB = (size_t)MS * D;
    s.H = sb; s.US = sb + SB; s.SZS = sb + 2 * SB; s.Q = sb + 3 * SB; s.SZA = sb + 4 * SB; s.SGS = sb + 5 * SB; s.SGA = sb + 6 * SB;
    s.YG = sb + 7 * SB; s.V = sb + 8 * SB; s.T1 = sb + 9 * SB; s.MM = sb + 10 * SB; s.y = p.out + OY_S;
}
template <class Epi>
static void gemm_naive(hipStream_t st, const bf16_t* A, const bf16_t* Bt, int M, int N, int K, Epi e) {
    const size_t tot = (size_t)M * N;
    hipLaunchKernelGGL(k_gemm_naive<Epi>, dim3((unsigned)((tot + 255) / 256)), dim3(256), 0, st, A, Bt, M, N, K, 0, e);
}
static int g_grid = 0;
static void launch_mega(hipStream_t stream, const P& p, int lo, int hi, int li) {
    Args a{}; a.p = p; a.ph_lo = lo; a.ph_hi = hi; a.li = li; a.pad = 0;
    hipLaunchKernelGGL(mega, dim3(g_grid), dim3(NWAVES * 64), LDS_BYTES, stream, a);
    const hipError_t le = hipPeekAtLastError();
    if (le != hipSuccess) fprintf(stderr, "kernel_launch: mega launch [%d,%d) failed: %s\n", lo, hi, hipGetErrorName(le));
}
extern "C" void kernel_launch(void* const* d_in, const int* in_sizes, int n_in, void* d_out, int out_size, void* d_ws, size_t ws_size, hipStream_t stream) {
    if (n_in != 28 || (size_t)out_size != OUT_TOTAL || ws_size < WS_END) { fprintf(stderr, "kernel_launch: unexpected shapes n_in %d out %d ws %zu\n", n_in, out_size, ws_size); return; }
    if (g_grid == 0) {
        int dev = 0, cus = 0, per_cu = 0;
        if (hipGetDevice(&dev) != hipSuccess || hipDeviceGetAttribute(&cus, hipDeviceAttributeMultiprocessorCount, dev) != hipSuccess) { fprintf(stderr, "kernel_launch: device query failed\n"); g_grid = -1; return; }
        if (hipFuncSetAttribute((const void*)mega, hipFuncAttributeMaxDynamicSharedMemorySize, LDS_BYTES) != hipSuccess) { fprintf(stderr, "kernel_launch: hipFuncSetAttribute failed\n"); g_grid = -1; return; }
        if (hipOccupancyMaxActiveBlocksPerMultiprocessor(&per_cu, (const void*)mega, NWAVES * 64, LDS_BYTES) != hipSuccess || per_cu < 1) { fprintf(stderr, "kernel_launch: occupancy query says %d blocks/CU\n", per_cu); per_cu = 1; }
        (void)hipGetLastError();
        g_grid = cus;
        if (g_grid != 256) fprintf(stderr, "kernel_launch: note: %d CUs (built for 256)\n", g_grid);
    }
    if (g_grid < 0) return;
    P p{}; fill_params(p, d_in, d_out, d_ws);
    hipMemsetAsync((char*)d_ws + WS_CTL, 0, CTL_ZERO_BYTES, stream);
    const Rows drp = p.rp, drs = p.rs;
    hipLaunchKernelGGL(k_mod, dim3((130 * 3072 + 255) / 256), dim3(256), 0, stream, p);
    hipLaunchKernelGGL(k_tables, dim3(16), dim3(256), 0, stream, p);
    hipLaunchKernelGGL(k_transpose, dim3((unsigned)(((size_t)D * DIN + 255) / 256)), dim3(256), 0, stream, p.in[10], p.win, D, DIN);
    hipLaunchKernelGGL(k_transpose, dim3(4096), dim3(256), 0, stream, p.in[19], p.wglu, D, D);
    hipLaunchKernelGGL(k_transpose, dim3(4096), dim3(256), 0, stream, p.in[23], p.wbs, D, D);
    hipLaunchKernelGGL(k_transpose, dim3(4096), dim3(256), 0, stream, p.in[24], p.wba, D, D);
    hipLaunchKernelGGL(k_transpose, dim3(4096), dim3(256), 0, stream, p.in[25], p.wout, D, D);
    hipLaunchKernelGGL(k_h, dim3((unsigned)(((size_t)MP * D + 255) / 256)), dim3(256), 0, stream, p, p.rp);
    hipLaunchKernelGGL(k_h, dim3((unsigned)(((size_t)MS * D + 255) / 256)), dim3(256), 0, stream, p, p.rs);
    hipLaunchKernelGGL(k_cache_shift, dim3((unsigned)(((size_t)MS * 127 * KVW + 255) / 256)), dim3(256), 0, stream, p);
    launch_mega(stream, p, 2, 3, 0);
    gemm_naive(stream, p.rs.H, p.win, MS, DIN, D, EpiInproj{p, 1, 0});
    hipLaunchKernelGGL(k_ssm_naive, dim3(BATCH * NG), dim3(64), 0, stream, p, p.rp, SEQ, 0);
    hipLaunchKernelGGL(k_ssm_naive, dim3(MS * NG), dim3(64), 0, stream, p, p.rs, 1, 0);
    hipLaunchKernelGGL(k_attn_naive, dim3((NH * MP + 63) / 64), dim3(64), 0, stream, p);
    hipLaunchKernelGGL(k_attn_sample_naive, dim3((MS * NH + 63) / 64), dim3(64), 0, stream, p);
    launch_mega(stream, p, 5, 8, 1);
    gemm_naive(stream, p.rs.YG, p.wglu, MS, D, D, EpiGlu{p.in[20], drs});
    gemm_naive(stream, p.rs.Q, p.wba, MS, D, D, EpiBa{drs});
    gemm_naive(stream, p.rs.V, p.wbs, MS, D, D, EpiBs{drs});
    gemm_naive(stream, p.rs.MM, p.wout, MS, D, D, EpiOut{p.mod, drs});
    hipLaunchKernelGGL(k_ln, dim3(MP / 4), dim3(256), 0, stream, p, p.rp);
    hipLaunchKernelGGL(k_ln, dim3(MS / 4), dim3(256), 0, stream, p, p.rs);
}
```

```cpp
#include <hip/hip_runtime.h>
#include <cstdio>
#include <cstdint>

typedef unsigned short bf16_t;

constexpr int D = 1024, BATCH = 2, SEQ = 8192, MP = BATCH * SEQ, MS = 128;
constexpr int DIN = 6656, NG = 64, NP = 64, GC = 16, NH = 16, HD = 64, NKV = 4, KVW = 256, WIN = 128;
constexpr float LN_EPS = 1e-5f, ALPHA = 1.189207115002721f, LOG2E = 1.4426950408889634f;
constexpr float QSCALE = 0.125f * LOG2E;

constexpr size_t OY_P = 0, OY_S = 16777216, OP_HR = 16908288, OP_HI = 16916480, OP_K = 16924672, OP_V = 16990208,
                 OS_HR = 17055744, OS_HI = 17580032, OS_K = 18104320, OS_V = 22298624, OUT_TOTAL = 26492928;

constexpr size_t MiB = 1u << 20;
constexpr size_t WS_CTL = 0;
constexpr size_t WS_MOD = 1 * MiB;
constexpr size_t WS_AR = 3 * MiB;
constexpr size_t WS_BBF = WS_AR + 4 * 16384;
constexpr size_t WS_BB = WS_BBF + 524288;
constexpr size_t WS_CMT = WS_BB + 262144;
constexpr size_t WS_BIAS = WS_CMT + 262144;
constexpr size_t WS_WIN = 8 * MiB;
constexpr size_t WS_WGLU = 21 * MiB, WS_WBS = 23 * MiB, WS_WBA = 25 * MiB, WS_WOUT = 27 * MiB;
constexpr size_t WS_E = 29 * MiB;
constexpr size_t WS_SAMPLE = 33 * MiB;
constexpr size_t WS_K = 36 * MiB;
constexpr size_t WS_VT = 44 * MiB;
constexpr size_t WS_US = 52 * MiB, WS_SZS = 84 * MiB, WS_Q = 116 * MiB, WS_SGS = 148 * MiB, WS_SGA = 180 * MiB, WS_SZA = 212 * MiB;
constexpr size_t WS_END = 244 * MiB;

__device__ __forceinline__ float bf2f(bf16_t v) { return __uint_as_float((unsigned)v << 16); }
__device__ __forceinline__ bf16_t f2bf(float f) { unsigned u = __float_as_uint(f); return (bf16_t)((u + 0x7fffu + ((u >> 16) & 1u)) >> 16); }
__device__ __forceinline__ float sigmoidf_(float x) { return 1.f / (1.f + __expf(-x)); }
__device__ __forceinline__ float siluf_(float x) { return x / (1.f + __expf(-x)); }
__device__ __forceinline__ float gelu_tanh(float x) { const float z = 0.7978845608028654f * (x + 0.044715f * x * x * x); return x * (1.f - 1.f / (1.f + __expf(2.f * z))); }

struct Rows {
    int M, is_sample;
    const float* x;
    bf16_t *H, *US, *SZS, *Q, *SZA, *SGS, *SGA, *YG, *V, *T1, *MM;
    float* y;
};
struct P {
    const float* in[28];
    float* out;
    unsigned char* ws;
    Rows rp, rs;
    float* mod;
    float *ar, *ai, *atr, *ati, *bbf; bf16_t *bb, *cmt; float* biasl;
    bf16_t *win, *wglu, *wbs, *wba, *wout;
    float* E; bf16_t *K, *VT;
};
__device__ __forceinline__ int modrow(const Rows& r, int row) { return r.is_sample ? 2 + row : row / SEQ; }

namespace pg8 {
#define PG8_LAS __attribute__((address_space(3)))
typedef unsigned short bf16_t;
typedef short bf16x8 __attribute__((ext_vector_type(8)));
typedef float f32x4 __attribute__((ext_vector_type(4)));
typedef unsigned u32x4 __attribute__((ext_vector_type(4)));
constexpr int BM = 256, BK = 64, HALF = 128, HTB = HALF * BK * 2  , STAGE_BYTES = 8 * HTB, NXCD = 8, WGM = 8;

__host__ __device__ __forceinline__ int lds_byte(int r, int c) { const int st = (r >> 4) * 2 + (c >> 5), rr = r & 15, cc = c & 31, ob = rr * 64 + cc * 2; return st * 1024 + (ob ^ (((ob >> 9) & 1) << 5)); }
__host__ __device__ __forceinline__ void stage_rc(int b, int& R, int& C) { const int st = b / 1024, sb = b % 1024, swz = sb ^ (((sb >> 9) & 1) << 5); R = (st >> 1) * 16 + swz / 64; C = (st & 1) * 32 + (swz % 64) / 2; }
__host__ __device__ __forceinline__ int perm32(int rho) { const int n = rho >> 4, i = rho & 15; return 8 * (i >> 2) + 4 * n + (i & 3); }

struct Unit { int pm, pn; };
struct Gemm { const bf16_t* A; const bf16_t* Bt; int M, N, K; };

struct StaticOrder {
    int nM, nN, nwg, G, c;
    __host__ __device__ void init(int M, int N, int G_, int c_) { nM = M / BM; nN = N / BM; nwg = nM * nN; G = G_; c = c_; }
    __host__ __device__ bool next(int i, Unit& u) const {
        const long L = (long)i * G + c; if (L >= nwg) return false;
        int wgid = (int)L; { const int q = nwg / NXCD, r = nwg % NXCD, xcd = wgid % NXCD, off = wgid / NXCD; wgid = (xcd < r ? xcd * (q + 1) : r * (q + 1) + (xcd - r) * q) + off; }
        const int nig = WGM * nN, gid = wgid / nig, fm = gid * WGM, gsz = (nM - fm) < WGM ? (nM - fm) : WGM;
        u.pm = fm + ((wgid % nig) % gsz); u.pn = (wgid % nig) / gsz; return true;
    }
    __device__ __forceinline__ void a_ready(const Unit&) const {}
    __device__ __forceinline__ void done(const Unit&) const {}
};

__device__ __forceinline__ unsigned cvt_pk_bf16(float lo, float hi) { unsigned r; asm volatile("v_cvt_pk_bf16_f32 %0, %1, %2" : "=v"(r) : "v"(lo), "v"(hi)); return r; }
typedef float f32x2 __attribute__((ext_vector_type(2)));
__device__ __forceinline__ float sig_(float x) { return 1.f / (1.f + __expf(-x)); }
__device__ __forceinline__ u32x4 pack8(const f32x4& a, const f32x4& b) { u32x4 w; w.x = cvt_pk_bf16(a[0], a[1]); w.y = cvt_pk_bf16(a[2], a[3]); w.z = cvt_pk_bf16(b[0], b[1]); w.w = cvt_pk_bf16(b[2], b[3]); return w; }
__device__ __forceinline__ void unpack8(const u32x4& w, f32x4& a, f32x4& b) {
    a[0] = __uint_as_float(w.x << 16); a[1] = __uint_as_float(w.x & 0xffff0000u); a[2] = __uint_as_float(w.y << 16); a[3] = __uint_as_float(w.y & 0xffff0000u);
    b[0] = __uint_as_float(w.z << 16); b[1] = __uint_as_float(w.z & 0xffff0000u); b[2] = __uint_as_float(w.w << 16); b[3] = __uint_as_float(w.w & 0xffff0000u);
}
struct EpiInprojFast {
    static constexpr bool PERM = true, AFTER_DRAIN = false;
    bf16_t *US, *SZS, *Q, *SZA, *SGS, *SGA, *K, *VT; float* out;
    __device__ __forceinline__ void operator()(const f32x4 (&acc)[2][2][4][2], const Unit& u, int wr, int wc, int fr, int fq) const {
        const int pn = u.pn, row0 = u.pm * BM + wr * 64 + fr, cl0 = wc * 32 + 8 * fq;
        const int b = u.pm >> 5, tb = (u.pm & 31) * BM + wr * 64 + fr;
        if (pn == 13) {
#pragma unroll
            for (int ai = 0; ai < 2; ++ai)
#pragma unroll
                for (int m = 0; m < 4; ++m) { const int t = tb + ai * HALF + m * 16;
#pragma unroll
                    for (int bj = 0; bj < 2; ++bj)
#pragma unroll
                        for (int n = 0; n < 2; ++n)
#pragma unroll
                            for (int e = 0; e < 4; ++e) { const int c = bj * HALF + cl0 + 4 * n + e;
                                VT[((size_t)(b * NKV + (c >> 6)) * HD + (c & 63)) * SEQ + t] = (bf16_t)(cvt_pk_bf16(acc[ai][bj][m][n][e], 0.f) & 0xffffu); }
                    if (ai == 1 && (u.pm & 31) == 31) { float* o = out + OP_V + ((size_t)(b * WIN) + (wr * 64 + m * 16 + fr)) * KVW + cl0;
#pragma unroll
                        for (int bj = 0; bj < 2; ++bj) { *(f32x4*)(o + bj * HALF) = acc[ai][bj][m][0]; *(f32x4*)(o + bj * HALF + 4) = acc[ai][bj][m][1]; } } }
            return;
        }
        bf16_t* base; int ld = D, colt, mode;
        if (pn < 4) { base = US; colt = pn * BM; mode = 0; }
        else if (pn < 8) { base = SZS; colt = (pn - 4) * BM; mode = 1; }
        else if (pn < 12) { base = Q; colt = (pn - 8) * BM; mode = 3; }
        else if (pn == 12) { base = K; colt = 0; mode = 0; ld = KVW; }
        else if (pn < 18) { base = SZA; colt = (pn - 14) * BM; mode = 1; }
        else if (pn < 22) { base = SGS; colt = (pn - 18) * BM; mode = 2; }
        else { base = SGA; colt = (pn - 22) * BM; mode = 2; }
#pragma unroll
        for (int ai = 0; ai < 2; ++ai)
#pragma unroll
            for (int m = 0; m < 4; ++m) { bf16_t* rowp = base + (size_t)(row0 + ai * HALF + m * 16) * ld + colt + cl0;
#pragma unroll
                for (int bj = 0; bj < 2; ++bj) { f32x4 v0 = acc[ai][bj][m][0], v1 = acc[ai][bj][m][1];
                    if (mode == 1) {
#pragma unroll
                        for (int e = 0; e < 4; ++e) { v0[e] = v0[e] * sig_(v0[e]); v1[e] = v1[e] * sig_(v1[e]); } }
                    else if (mode == 2) {
#pragma unroll
                        for (int e = 0; e < 4; ++e) { v0[e] = sig_(v0[e]); v1[e] = sig_(v1[e]); } }
                    else if (mode == 3) { v0 = v0 * QSCALE; v1 = v1 * QSCALE; }
                    *(u32x4*)(rowp + bj * HALF) = pack8(v0, v1); }
                if (pn == 12 && ai == 1 && (u.pm & 31) == 31) { float* o = out + OP_K + ((size_t)(b * WIN) + (wr * 64 + m * 16 + fr)) * KVW + cl0;
#pragma unroll
                    for (int bj = 0; bj < 2; ++bj) { *(f32x4*)(o + bj * HALF) = acc[ai][bj][m][0]; *(f32x4*)(o + bj * HALF + 4) = acc[ai][bj][m][1]; } } }
    }
};
struct EpiGluFast {
    static constexpr bool PERM = true, AFTER_DRAIN = false;
    const bf16_t *YG, *SZS; bf16_t* V; const float* bglu;
    __device__ __forceinline__ void operator()(const f32x4 (&acc)[2][2][4][2], const Unit& u, int wr, int wc, int fr, int fq) const {
        const int row0 = u.pm * BM + wr * 64 + fr, col0 = u.pn * BM + wc * 32 + 8 * fq;
        f32x4 bv[2][2];
#pragma unroll
        for (int bj = 0; bj < 2; ++bj)
#pragma unroll
            for (int n = 0; n < 2; ++n) bv[bj][n] = *(const f32x4*)(bglu + col0 + bj * HALF + 4 * n);
#pragma unroll
        for (int ai = 0; ai < 2; ++ai)
#pragma unroll
            for (int m = 0; m < 4; ++m) { const size_t off = (size_t)(row0 + ai * HALF + m * 16) * D + col0;
#pragma unroll
                for (int bj = 0; bj < 2; ++bj) { f32x4 y0, y1, z0, z1; unpack8(*(const u32x4*)(YG + off + bj * HALF), y0, y1); unpack8(*(const u32x4*)(SZS + off + bj * HALF), z0, z1);
                    f32x4 v0 = acc[ai][bj][m][0] + bv[bj][0], v1 = acc[ai][bj][m][1] + bv[bj][1];
#pragma unroll
                    for (int e = 0; e < 4; ++e) { v0[e] = y0[e] * sig_(v0[e]) * z0[e]; v1[e] = y1[e] * sig_(v1[e]) * z1[e]; }
                    *(u32x4*)(V + off + bj * HALF) = pack8(v0, v1); } }
    }
};
template <bool HAS_ADD> struct EpiGateFast {
    static constexpr bool PERM = true, AFTER_DRAIN = false;
    const bf16_t *G, *ADD; bf16_t* O;
    __device__ __forceinline__ void operator()(const f32x4 (&acc)[2][2][4][2], const Unit& u, int wr, int wc, int fr, int fq) const {
        const int row0 = u.pm * BM + wr * 64 + fr, col0 = u.pn * BM + wc * 32 + 8 * fq;
#pragma unroll
        for (int ai = 0; ai < 2; ++ai)
#pragma unroll
            for (int m = 0; m < 4; ++m) { const size_t off = (size_t)(row0 + ai * HALF + m * 16) * D + col0;
#pragma unroll
                for (int bj = 0; bj < 2; ++bj) { f32x4 g0, g1; unpack8(*(const u32x4*)(G + off + bj * HALF), g0, g1);
                    f32x4 v0 = acc[ai][bj][m][0] * g0, v1 = acc[ai][bj][m][1] * g1;
                    if (HAS_ADD) { f32x4 a0, a1; unpack8(*(const u32x4*)(ADD + off + bj * HALF), a0, a1); v0 = v0 + a0; v1 = v1 + a1; }
                    *(u32x4*)(O + off + bj * HALF) = pack8(v0, v1); } }
    }
};
struct EpiOutFast {
    static constexpr bool PERM = false, AFTER_DRAIN = false;
    const float* x; const float* mod; float* y;
    __device__ __forceinline__ void operator()(const f32x4 (&acc)[2][2][4][2], const Unit& u, int wr, int wc, int fr, int fq) const {
        const int row0 = u.pm * BM + wr * 64 + fr, col0 = u.pn * BM + wc * 32 + 4 * fq;
        const float* gate = mod + (size_t)(u.pm >> 5) * 3072 + 2048;
        f32x4 gv[2][2];
#pragma unroll
        for (int bj = 0; bj < 2; ++bj)
#pragma unroll
            for (int n = 0; n < 2; ++n) gv[bj][n] = *(const f32x4*)(gate + col0 + bj * HALF + n * 16);
#pragma unroll
        for (int ai = 0; ai < 2; ++ai)
#pragma unroll
            for (int m = 0; m < 4; ++m) { const size_t off = (size_t)(row0 + ai * HALF + m * 16) * D + col0;
#pragma unroll
                for (int bj = 0; bj < 2; ++bj)
#pragma unroll
                    for (int n = 0; n < 2; ++n) { const f32x4 xv = *(const f32x4*)(x + off + bj * HALF + n * 16);
                        *(f32x4*)(y + off + bj * HALF + n * 16) = xv * ALPHA + gv[bj][n] * acc[ai][bj][m][n]; } }
    }
};

template <class Epi, class Sched, bool ALIGN_EPI = false, bool SP2 = false>
__device__ __forceinline__ void gemm_phase(PG8_LAS unsigned char* lds, const Gemm g, const Sched& S, const Epi& E) {
    int tid_ = threadIdx.x; asm volatile("" : "+v"(tid_)); const int tid = tid_, wid = __builtin_amdgcn_readfirstlane(tid >> 6), lane = tid & 63, wr = wid >> 2, wc = wid & 3, fr = lane & 15, fq = lane >> 4;
    const int K = g.K, nt = K / BK;
    unsigned voffA[2], voffB[2];
#pragma unroll
    for (int i = 0; i < 2; ++i) { int R, C; stage_rc(tid * 16 + i * 8192, R, C); const int Rb = Epi::PERM ? ((R & ~31) + perm32(R & 31)) : R;
        voffA[i] = (unsigned)(R * K + C) * 2u; voffB[i] = (unsigned)(Rb * K + C) * 2u; }
    const size_t kstep = (size_t)(BK * 2);
    const size_t hstep = (size_t)HALF * K * 2;
    const size_t tstep = 2 * hstep;
    const unsigned ldsw = (unsigned)wid * 1024u;
    const int aoff = lds_byte(wr * 64 + fr, fq * 8), boff = lds_byte(wc * 32 + fr, fq * 8);
#define PG8_SA(b, h) (((b) * 2 + (h)) * HTB)
#define PG8_SB(b, h) ((4 + (b) * 2 + (h)) * HTB)
#define PG8_STAGE(bufoff, gbase, voff) do { _Pragma("unroll") for (int _i = 0; _i < 2; ++_i) \
        __builtin_amdgcn_global_load_lds((const unsigned*)((const char*)(gbase) + (voff)[_i]), (PG8_LAS unsigned*)(lds + (bufoff) + ldsw + _i * 8192), 16, 0, 0); } while (0)
#define PG8_LDA(dst, b, h) do { _Pragma("unroll") for (int m = 0; m < 4; ++m) _Pragma("unroll") for (int k = 0; k < 2; ++k) dst[m][k] = *(const PG8_LAS bf16x8*)(lds + PG8_SA(b, h) + aoff + m * 2048 + k * 1024); } while (0)
#define PG8_LDB(dst, b, h) do { _Pragma("unroll") for (int n = 0; n < 2; ++n) _Pragma("unroll") for (int k = 0; k < 2; ++k) dst[n][k] = *(const PG8_LAS bf16x8*)(lds + PG8_SB(b, h) + boff + n * 2048 + k * 1024); } while (0)
#define PG8_MMA(ai, bj, At, Bt) do { __builtin_amdgcn_s_setprio(1); _Pragma("unroll") for (int m = 0; m < 4; ++m) _Pragma("unroll") for (int n = 0; n < 2; ++n) _Pragma("unroll") for (int k = 0; k < 2; ++k) \
        acc[ai][bj][m][n] = __builtin_amdgcn_mfma_f32_16x16x32_bf16(Bt[n][k], At[m][k], acc[ai][bj][m][n], 0, 0, 0); __builtin_amdgcn_s_setprio(0); } while (0)
#define PG8_WAIT_V(n) asm volatile("s_waitcnt vmcnt(" #n ")" ::: "memory")
#define PG8_WAIT_L(n) asm volatile("s_waitcnt lgkmcnt(" #n ")" ::: "memory")
#define PG8_BAR __builtin_amdgcn_s_barrier()
#define PG8_SCHED __builtin_amdgcn_sched_barrier(0)
    Unit cur, nxt; int ui = 0;
    if (!S.next(0, cur)) return;
    f32x4 acc[2][2][4][2];
#pragma unroll
    for (int a = 0; a < 2; ++a)
#pragma unroll
        for (int b = 0; b < 2; ++b)
#pragma unroll
            for (int m = 0; m < 4; ++m)
#pragma unroll
                for (int n = 0; n < 2; ++n) acc[a][b][m][n] = (f32x4){0.f, 0.f, 0.f, 0.f};
    bf16x8 At[4][2], B0[2][2], B1[2][2];
    const char* cA = (const char*)g.A + (size_t)cur.pm * tstep; const char* cB = (const char*)g.Bt + (size_t)cur.pn * tstep;
    S.a_ready(cur);
    if constexpr (SP2) {
        PG8_STAGE(PG8_SB(0, 0), cB, voffB); PG8_STAGE(PG8_SB(0, 1), cB + hstep, voffB); PG8_STAGE(PG8_SA(0, 0), cA, voffA); PG8_STAGE(PG8_SA(0, 1), cA + hstep, voffA);
        if (wr == 1) PG8_BAR;
        PG8_WAIT_V(2); PG8_BAR;
        PG8_STAGE(PG8_SB(1, 0), cB + kstep, voffB); PG8_STAGE(PG8_SA(1, 0), cA + kstep, voffA); PG8_STAGE(PG8_SB(1, 1), cB + hstep + kstep, voffB);
        PG8_WAIT_V(6); PG8_BAR;
    } else {
        PG8_STAGE(PG8_SB(0, 0), cB, voffB); PG8_STAGE(PG8_SA(0, 0), cA, voffA); PG8_STAGE(PG8_SB(0, 1), cB + hstep, voffB); PG8_STAGE(PG8_SA(0, 1), cA + hstep, voffA);
        if (wr == 1) PG8_BAR;
        PG8_WAIT_V(4); PG8_BAR;
        PG8_STAGE(PG8_SB(1, 0), cB + kstep, voffB); PG8_STAGE(PG8_SA(1, 0), cA + kstep, voffA); PG8_STAGE(PG8_SB(1, 1), cB + hstep + kstep, voffB);
        PG8_WAIT_V(6); PG8_BAR;
    }
    for (;;) {
        const bool has_next = S.next(ui + 1, nxt);
        const char* nA = has_next ? (const char*)g.A + (size_t)nxt.pm * tstep : cA; const char* nB = has_next ? (const char*)g.Bt + (size_t)nxt.pn * tstep : cB;
        for (int t = 0; t < nt; t += 2) {
            const bool last = (t == nt - 2);
            const char* a1 = cA + (size_t)(t + 1) * kstep;
            const char* a2 = last ? nA : cA + (size_t)(t + 2) * kstep; const char* b2 = last ? nB : cB + (size_t)(t + 2) * kstep;
            const char* a3 = a2 + kstep; const char* b3 = b2 + kstep;
            if (last && has_next) S.a_ready(nxt);
            if constexpr (SP2) {
            PG8_LDB(B0, 0, 0); PG8_LDB(B1, 0, 1); PG8_SCHED; PG8_LDA(At, 0, 0); PG8_STAGE(PG8_SA(1, 1), a1 + hstep, voffA);
            PG8_WAIT_V(8); PG8_WAIT_L(0); PG8_BAR; PG8_MMA(0, 0, At, B0); PG8_MMA(0, 1, At, B1); PG8_BAR; PG8_SCHED;
            PG8_LDA(At, 0, 1); PG8_STAGE(PG8_SB(0, 0), b2, voffB); PG8_STAGE(PG8_SB(0, 1), b2 + hstep, voffB); PG8_STAGE(PG8_SA(0, 0), a2, voffA);
            PG8_WAIT_V(8); PG8_WAIT_L(0); PG8_BAR; PG8_MMA(1, 0, At, B0); PG8_MMA(1, 1, At, B1); PG8_BAR; PG8_SCHED;
            PG8_LDB(B0, 1, 0); PG8_LDB(B1, 1, 1); PG8_SCHED; PG8_LDA(At, 1, 0); PG8_STAGE(PG8_SA(0, 1), a2 + hstep, voffA);
            PG8_WAIT_V(8); PG8_WAIT_L(0); PG8_BAR; PG8_MMA(0, 0, At, B0); PG8_MMA(0, 1, At, B1); PG8_BAR; PG8_SCHED;
            PG8_LDA(At, 1, 1); PG8_STAGE(PG8_SB(1, 0), b3, voffB); PG8_STAGE(PG8_SB(1, 1), b3 + hstep, voffB); PG8_STAGE(PG8_SA(1, 0), a3, voffA);
            PG8_WAIT_V(8); PG8_WAIT_L(0); PG8_BAR; PG8_MMA(1, 0, At, B0); PG8_MMA(1, 1, At, B1); PG8_BAR; PG8_SCHED;
            } else {
            PG8_LDB(B0, 0, 0); PG8_SCHED; PG8_LDA(At, 0, 0); PG8_STAGE(PG8_SA(1, 1), a1 + hstep, voffA);
            PG8_WAIT_L(8); PG8_BAR; PG8_WAIT_L(0); PG8_MMA(0, 0, At, B0); PG8_BAR; PG8_SCHED;
            PG8_LDB(B1, 0, 1); PG8_STAGE(PG8_SB(0, 0), b2, voffB);
            PG8_BAR; PG8_WAIT_L(0); PG8_MMA(0, 1, At, B1); PG8_BAR;
            PG8_LDA(At, 0, 1); PG8_STAGE(PG8_SA(0, 0), a2, voffA);
            PG8_BAR; PG8_WAIT_L(0); PG8_MMA(1, 0, At, B0); PG8_BAR; PG8_SCHED;
            PG8_STAGE(PG8_SB(0, 1), b2 + hstep, voffB);
            PG8_WAIT_V(6); PG8_BAR; PG8_MMA(1, 1, At, B1); PG8_BAR;
            PG8_LDB(B0, 1, 0); PG8_SCHED; PG8_LDA(At, 1, 0); PG8_STAGE(PG8_SA(0, 1), a2 + hstep, voffA);
            PG8_WAIT_L(8); PG8_BAR; PG8_WAIT_L(0); PG8_MMA(0, 0, At, B0); PG8_BAR; PG8_SCHED;
            PG8_LDB(B1, 1, 1); PG8_STAGE(PG8_SB(1, 0), b3, voffB);
            PG8_BAR; PG8_WAIT_L(0); PG8_MMA(0, 1, At, B1); PG8_BAR;
            PG8_LDA(At, 1, 1); PG8_STAGE(PG8_SA(1, 0), a3, voffA);
            PG8_BAR; PG8_WAIT_L(0); PG8_MMA(1, 0, At, B0); PG8_BAR; PG8_SCHED;
            PG8_STAGE(PG8_SB(1, 1), b3 + hstep, voffB);
            PG8_WAIT_V(6); PG8_BAR; PG8_MMA(1, 1, At, B1); PG8_BAR;
            }
        }
        if constexpr (ALIGN_EPI) { if (wr == 0) PG8_BAR; }
        if constexpr (!Epi::AFTER_DRAIN) { E(acc, cur, wr, wc, fr, fq); S.done(cur); }
        if (!has_next) break;
#pragma unroll
        for (int a = 0; a < 2; ++a)
#pragma unroll
            for (int b = 0; b < 2; ++b)
#pragma unroll
                for (int m = 0; m < 4; ++m)
#pragma unroll
                    for (int n = 0; n < 2; ++n) acc[a][b][m][n] = (f32x4){0.f, 0.f, 0.f, 0.f};
        cur = nxt; cA = nA; cB = nB; ++ui;
        if constexpr (ALIGN_EPI) { if (wr == 1) PG8_BAR; }
    }
    PG8_WAIT_V(0);
    if constexpr (!ALIGN_EPI) { if (wr == 0) PG8_BAR; }
    PG8_BAR;
    if constexpr (Epi::AFTER_DRAIN) { E.fused(acc, cur, wr, wc, fr, fq, lds, wid, lane); S.done(cur); }
#undef PG8_SA
#undef PG8_SB
#undef PG8_STAGE
#undef PG8_LDA
#undef PG8_LDB
#undef PG8_MMA
#undef PG8_WAIT_V
#undef PG8_WAIT_L
#undef PG8_BAR
#undef PG8_SCHED
}
}
#define GAS __attribute__((address_space(1)))
#define LAS __attribute__((address_space(3)))
typedef unsigned v4u __attribute__((ext_vector_type(4)));
typedef float f32x4 __attribute__((ext_vector_type(4)));
typedef short bf16x8 __attribute__((ext_vector_type(8)));
typedef GAS unsigned gu32;
#define RLX_AGENT __ATOMIC_RELAXED, __HIP_MEMORY_SCOPE_AGENT
#define LDS_WAIT() asm volatile("s_waitcnt lgkmcnt(0)" ::: "memory")
#define VM_WAIT() asm volatile("s_waitcnt vmcnt(0)" ::: "memory")
#define XB_TMO      128
#define XB_XCNT(j)  (256  + 64 * (j))
#define XB_XSUB(j)  (1280 + 64 * (j))
#define XB_XGEN(j)  (2304 + 64 * (j))
#define XB_TOP      3328
#define XB_TOPGEN   3392
#define XCD_BAR_WORDS 3456
#define XB_SPIN_CAP (1u << 18)

__device__ __forceinline__ unsigned xb_ld(unsigned* p)              { return __hip_atomic_load(p, __ATOMIC_RELAXED, __HIP_MEMORY_SCOPE_AGENT); }
__device__ __forceinline__ unsigned xb_add(unsigned* p, unsigned v) { return __hip_atomic_fetch_add(p, v, __ATOMIC_RELAXED, __HIP_MEMORY_SCOPE_AGENT); }
__device__ __forceinline__ unsigned xb_xcc_id() { return (unsigned)__builtin_amdgcn_s_getreg((3 << 11) | 20) & 0xFu; }
#define XB_SPIN(cond, bar) do { unsigned _sp = 0; while (cond) { __builtin_amdgcn_s_sleep(1); \
    if ((++_sp & 255u) == 0u) { if (xb_ld(&(bar)[XB_TMO])) break; if (_sp > XB_SPIN_CAP) { atomicAdd(&(bar)[XB_TMO], 1u); break; } } } } while (0)

struct XcdBarrier {
    unsigned* bar; unsigned x;
    volatile LAS unsigned* st;
};

__device__ __forceinline__ XcdBarrier xcd_barrier_post(unsigned* bar, volatile LAS unsigned* st) {
    XcdBarrier b; b.bar = bar; b.x = xb_xcc_id(); b.st = st;
    if (threadIdx.x == 0) (void)xb_add(&bar[XB_XCNT(b.x)], 1u);
    return b;
}
__device__ __forceinline__ void xcd_barrier_complete(unsigned* bar, unsigned x, unsigned& nloc, unsigned& nx) {
    const unsigned G = gridDim.x * gridDim.y * gridDim.z;
    unsigned sum, cnt, mine, sp = 0u;
    for (;;) {
        sum = 0u; cnt = 0u; mine = 0u;
#pragma unroll
        for (unsigned j = 0; j < 16; ++j) { const unsigned c = xb_ld(&bar[XB_XCNT(j)]); sum += c; cnt += (c > 0u) ? 1u : 0u; mine = (j == x) ? c : mine; }
        if (sum == G) break;
        __builtin_amdgcn_s_sleep(1);
        if ((++sp & 255u) == 0u) { if (xb_ld(&bar[XB_TMO])) break; if (sp > XB_SPIN_CAP) { atomicAdd(&bar[XB_TMO], 1u); break; } }
    }
    nloc = mine > 0u ? mine : 1u; nx = cnt > 0u ? cnt : 1u;
}

__device__ __forceinline__ void xcd_barrier(const XcdBarrier& b) {
    asm volatile("s_waitcnt vmcnt(0)" ::: "memory");
    __syncthreads();
    if (threadIdx.x == 0) {
        unsigned* bar = b.bar;
        __builtin_amdgcn_s_waitcnt(0);
        unsigned nloc = b.st[0], nx = b.st[1];
        if (nloc == 0u) { xcd_barrier_complete(bar, b.x, nloc, nx); b.st[0] = nloc; b.st[1] = nx; }
        const unsigned old = xb_add(&bar[XB_XSUB(b.x)], 1u);
        const unsigned gen = old / nloc;
        if (old + 1u == (gen + 1u) * nloc) {
            __builtin_amdgcn_fence(__ATOMIC_RELEASE, "agent");
            asm volatile("s_waitcnt vmcnt(0)" ::: "memory");
            const unsigned og = xb_add(&bar[XB_TOP], 1u);
            const unsigned tg = og / nx;
            if (og + 1u == (tg + 1u) * nx) xb_add(&bar[XB_TOPGEN], 1u);
            else XB_SPIN(xb_ld(&bar[XB_TOPGEN]) == tg, bar);
            __builtin_amdgcn_fence(__ATOMIC_ACQUIRE, "agent");
            xb_add(&bar[XB_XGEN(b.x)], 1u);
            asm volatile("s_waitcnt vmcnt(0)" ::: "memory");
        } else {
            XB_SPIN(xb_ld(&bar[XB_XGEN(b.x)]) == gen, bar);
            __builtin_amdgcn_fence(__ATOMIC_ACQUIRE, "agent");
            asm volatile("s_waitcnt vmcnt(0)" ::: "memory");
        }
    }
    __syncthreads();
}

struct EpiInproj {
    P pp; int sample, pad;
    __device__ void operator()(int row, int col, float v) const {
        const P* p = &pp; const Rows& R = sample ? pp.rs : pp.rp;
        if (col < 1024) R.US[(size_t)row * D + col] = f2bf(v);
        else if (col < 2048) R.SZS[(size_t)row * D + col - 1024] = f2bf(siluf_(v));
        else if (col < 3072) R.Q[(size_t)row * D + col - 2048] = f2bf(v * QSCALE);
        else if (col < 3328) {
            const int c = col - 3072;
            if (R.is_sample) p->out[OS_K + ((size_t)row * WIN + 127) * KVW + c] = v;
            else { p->K[(size_t)row * KVW + c] = f2bf(v); const int b = row / SEQ, t = row % SEQ; if (t >= SEQ - WIN) p->out[OP_K + ((size_t)b * WIN + t - (SEQ - WIN)) * KVW + c] = v; }
        } else if (col < 3584) {
            const int c = col - 3328;
            if (R.is_sample) p->out[OS_V + ((size_t)row * WIN + 127) * KVW + c] = v;
            else { const int b = row / SEQ, t = row % SEQ; p->VT[((size_t)(b * NKV + (c >> 6)) * HD + (c & 63)) * SEQ + t] = f2bf(v); if (t >= SEQ - WIN) p->out[OP_V + ((size_t)b * WIN + t - (SEQ - WIN)) * KVW + c] = v; }
        } else if (col < 4608) R.SZA[(size_t)row * D + col - 3584] = f2bf(siluf_(v));
        else if (col < 5632) R.SGS[(size_t)row * D + col - 4608] = f2bf(sigmoidf_(v));
        else R.SGA[(size_t)row * D + col - 5632] = f2bf(sigmoidf_(v));
    }
};
struct EpiGlu {
    const float* bglu; Rows rr;
    __device__ void operator()(int row, int col, float v) const {
        const Rows* r = &rr; const size_t i = (size_t)row * D + col;
        r->V[i] = f2bf(bf2f(r->YG[i]) * sigmoidf_(v + bglu[col]) * bf2f(r->SZS[i]));
    }
};
struct EpiBa {
    Rows rr;
    __device__ void operator()(int row, int col, float v) const { const Rows* r = &rr; const size_t i = (size_t)row * D + col; r->T1[i] = f2bf(bf2f(r->SGA[i]) * v); }
};
struct EpiBs {
    Rows rr;
    __device__ void operator()(int row, int col, float v) const { const Rows* r = &rr; const size_t i = (size_t)row * D + col; r->MM[i] = f2bf(bf2f(r->SGS[i]) * v + bf2f(r->T1[i])); }
};
struct EpiOut {
    const float* mod; Rows rr;
    __device__ void operator()(int row, int col, float v) const {
        const Rows* r = &rr; const size_t i = (size_t)row * D + col;
        r->y[i] = ALPHA * r->x[i] + mod[(size_t)modrow(*r, row) * 3072 + 2048 + col] * v;
    }
};
template <class Epi>
__global__ void k_gemm_naive(const bf16_t* A, const bf16_t* Bt, int M, int N, int K, int pad, Epi epi) {
    const size_t idx = (size_t)blockIdx.x * blockDim.x + threadIdx.x;
    if (idx >= (size_t)M * N) return;
    const int row = (int)(idx / N), col = (int)(idx % N);
    const uint4* a = (const uint4*)(A + (size_t)row * K); const uint4* b = (const uint4*)(Bt + (size_t)col * K);
    float acc = 0.f;
    for (int k = 0; k < K / 8; ++k) {
        const uint4 av = a[k], bv = b[k];
        const unsigned aw[4] = {av.x, av.y, av.z, av.w}, bw[4] = {bv.x, bv.y, bv.z, bv.w};
#pragma unroll
        for (int j = 0; j < 4; ++j) { acc += __uint_as_float(aw[j] << 16) * __uint_as_float(bw[j] << 16); acc += __uint_as_float(aw[j] & 0xffff0000u) * __uint_as_float(bw[j] & 0xffff0000u); }
    }
    epi(row, col, acc);
}
constexpr int NWAVES = 8;
__device__ __forceinline__ unsigned pk_bf16(float lo, float hi) { return pg8::cvt_pk_bf16(lo, hi); }

__device__ __forceinline__ void phase_mod(const P& p, LAS unsigned char* L, int task) {
    const int cg = task % 48, rg = task / 48, tid = threadIdx.x, col = tid & 63, ks = tid >> 6;
    LAS float* cs = (LAS float*)L;
    {   const int r = tid & 31; const bool valid = (rg < 4) || (r < 2);
        const float* crow = (rg < 4) ? p.in[3] + (size_t)(rg * 32 + r) * D : p.in[2] + (size_t)(r & 1) * D;
        for (int i = 0; i < 64; ++i) { const int k = (tid >> 5) + 16 * i; const float v = crow[k]; cs[k * 32 + r] = valid ? v / (1.f + __expf(-v)) : 0.f; } }
    __syncthreads();
    float acc[32];
#pragma unroll
    for (int r = 0; r < 32; ++r) acc[r] = 0.f;
    const float* w = p.in[8] + (size_t)(ks * 128) * 3072 + cg * 64 + col;
#pragma unroll 4
    for (int k = 0; k < 128; ++k) {
        const float wv = w[(size_t)k * 3072];
        const LAS f32x4* c4 = (const LAS f32x4*)(cs + (ks * 128 + k) * 32);
#pragma unroll
        for (int j = 0; j < 8; ++j) { const f32x4 c = c4[j]; acc[4 * j + 0] += c[0] * wv; acc[4 * j + 1] += c[1] * wv; acc[4 * j + 2] += c[2] * wv; acc[4 * j + 3] += c[3] * wv; }
    }
    __syncthreads();
    LAS float* part = (LAS float*)L;
#pragma unroll
    for (int r = 0; r < 32; ++r) part[(ks * 32 + r) * 64 + col] = acc[r];
    __syncthreads();
#pragma unroll
    for (int i = 0; i < 4; ++i) { const int o = tid + 512 * i, rr = o >> 6, cc = o & 63; float s = p.in[9][cg * 64 + cc];
#pragma unroll
        for (int k2 = 0; k2 < 8; ++k2) s += part[(k2 * 32 + rr) * 64 + cc];
        if (rg < 4) p.mod[(size_t)(2 + rg * 32 + rr) * 3072 + cg * 64 + cc] = s; else if (rr < 2) p.mod[(size_t)rr * 3072 + cg * 64 + cc] = s; }
    __syncthreads();
}
__device__ __forceinline__ void phase_tables(const P& p, int idx) {
    if (idx < NG * NP) {
        const int g = idx / NP;
        const double lr = p.in[11][idx], li = p.in[12][idx], dt = exp((double)p.in[13][g]);
        const double mag = exp(lr * dt), ar = mag * cos(li * dt), ai = mag * sin(li * dt);
        const double den = lr * lr + li * li, nr = ar - 1.0, cr = (nr * lr + ai * li) / den, ci = (ai * lr - nr * li) / den;
        p.ar[idx] = (float)ar; p.ai[idx] = (float)ai;
        double pr = ar, pi = ai;
        for (int s = 0; s < 7; ++s) { const double nr2 = pr * pr - pi * pi, ni2 = 2.0 * pr * pi; pr = nr2; pi = ni2; }
        p.atr[idx] = (float)pr; p.ati[idx] = (float)pi;
        const int pp = idx % NP;
        for (int c = 0; c < GC; ++c) {
            const double br = p.in[14][(size_t)idx * GC + c], bi = p.in[15][(size_t)idx * GC + c];
            const float bbr = (float)(cr * br - ci * bi), bbi = (float)(cr * bi + ci * br);
            p.bbf[((size_t)(g * 2 + 0) * NP + pp) * GC + c] = bbr; p.bbf[((size_t)(g * 2 + 1) * NP + pp) * GC + c] = bbi;
            p.bb[((size_t)(g * 2 + 0) * NP + pp) * GC + c] = f2bf(bbr); p.bb[((size_t)(g * 2 + 1) * NP + pp) * GC + c] = f2bf(bbi);
            p.cmt[((size_t)g * GC + c) * 128 + 2 * pp + 0] = f2bf(p.in[16][((size_t)g * GC + c) * NP + pp]);
            p.cmt[((size_t)g * GC + c) * 128 + 2 * pp + 1] = f2bf(-p.in[17][((size_t)g * GC + c) * NP + pp]);
        }
    }
    if (idx < NH * 132) {
        const int h = idx / 132, d = idx % 132;
        float v = 0.f;
        if (d <= 128) {
            int bucket;
            if (d < 16) bucket = d;
            else { const float df = (float)d; int large = 16 + (int)(logf(df / 16.f) / logf(8.f) * 16.f); bucket = large < 31 ? large : 31; }
            v = p.in[22][bucket * NH + h] * LOG2E;
        }
        p.biasl[idx] = v;
    }
    if (idx < NH) p.biasl[NH * 132 + idx] = p.in[21][idx] * LOG2E;
}
__device__ __forceinline__ void transpose_item(const float* W, int K, int N, bf16_t* WT, LAS float* scr, int item, int lane) {
    const int nblk = N / 32, kb = item / nblk, nb = item % nblk, k0 = 64 * kb, n0 = 32 * nb;
#pragma unroll 8
    for (int i = 0; i < 32; ++i) { const int kk = 2 * i + (lane >> 5); scr[kk * 33 + (lane & 31)] = W[(size_t)(k0 + kk) * N + n0 + (lane & 31)]; }
    LDS_WAIT(); asm volatile("" ::: "memory");
    const int c = lane & 7;
#pragma unroll
    for (int j = 0; j < 4; ++j) { const int n = (lane >> 3) + 8 * j; const LAS float* s = scr + (8 * c) * 33 + n;
        v4u o; o.x = pk_bf16(s[0 * 33], s[1 * 33]); o.y = pk_bf16(s[2 * 33], s[3 * 33]); o.z = pk_bf16(s[4 * 33], s[5 * 33]); o.w = pk_bf16(s[6 * 33], s[7 * 33]);
        *(v4u*)(WT + (size_t)(n0 + n) * K + k0 + 8 * c) = o; }
    LDS_WAIT(); asm volatile("" ::: "memory");
}
__device__ __forceinline__ void h_row(const float* xrow, const float* m, bf16_t* hrow, int lane) {
    typedef unsigned u32x2 __attribute__((ext_vector_type(2)));
#pragma unroll
    for (int j = 0; j < 4; ++j) { const int i4 = lane + 64 * j;
        const f32x4 x = ((const f32x4*)xrow)[i4], sh = ((const f32x4*)m)[i4], sc = ((const f32x4*)(m + 1024))[i4];
        const f32x4 v = x * (sc + 1.f) + sh; u32x2 o; o.x = pk_bf16(v[0], v[1]); o.y = pk_bf16(v[2], v[3]); ((u32x2*)hrow)[i4] = o; }
}
__device__ __forceinline__ void phase_bulk(const P& p, LAS unsigned char* L, int gw, int NGW, int wave, int lane) {
    LAS float* scr = (LAS float*)(L + wave * 16384);
    constexpr int I_IN = (D / 64) * (DIN / 32), I_SQ = (D / 64) * (D / 32);
    for (int it = gw; it < I_IN + 4 * I_SQ; it += NGW) {
        int r = it;
        if (r < I_IN) { transpose_item(p.in[10], D, DIN, p.win, scr, r, lane); continue; } r -= I_IN;
        if (r < I_SQ) { transpose_item(p.in[19], D, D, p.wglu, scr, r, lane); continue; } r -= I_SQ;
        if (r < I_SQ) { transpose_item(p.in[23], D, D, p.wbs, scr, r, lane); continue; } r -= I_SQ;
        if (r < I_SQ) { transpose_item(p.in[24], D, D, p.wba, scr, r, lane); continue; } r -= I_SQ;
        transpose_item(p.in[25], D, D, p.wout, scr, r, lane);
    }
    for (int m = gw; m < MP + MS; m += NGW) {
        if (m < MP) h_row(p.rp.x + (size_t)m * D, p.mod + (size_t)(m / SEQ) * 3072, p.rp.H + (size_t)m * D, lane);
        else { const int b = m - MP; h_row(p.rs.x + (size_t)b * D, p.mod + (size_t)(2 + b) * 3072, p.rs.H + (size_t)b * D, lane); }
    }
    constexpr int PER_B = 127 * KVW / 4, TOT = MS * PER_B;
    for (int i = gw * 64 + lane; i < 2 * TOT; i += NGW * 64) {
        const int which = i >= TOT, j = which ? i - TOT : i, b = j / PER_B, rem = j % PER_B;
        const f32x4 v = ((const f32x4*)(p.in[6 + which] + (size_t)b * WIN * KVW + KVW))[rem];
        ((f32x4*)(p.out + (which ? OS_V : OS_K) + (size_t)b * WIN * KVW))[rem] = v;
    }
}
__device__ __forceinline__ void ln_row(float* y, const float* g, const float* bta, int lane) {
    f32x4 v[4]; float s = 0.f;
#pragma unroll
    for (int j = 0; j < 4; ++j) { v[j] = ((const f32x4*)y)[lane + 64 * j]; s += (v[j][0] + v[j][1]) + (v[j][2] + v[j][3]); }
#pragma unroll
    for (int o = 1; o < 64; o <<= 1) s += __shfl_xor(s, o);
    const float mean = s * (1.f / D); float q = 0.f;
#pragma unroll
    for (int j = 0; j < 4; ++j) { v[j] = v[j] - mean; q += (v[j][0] * v[j][0] + v[j][1] * v[j][1]) + (v[j][2] * v[j][2] + v[j][3] * v[j][3]); }
#pragma unroll
    for (int o = 1; o < 64; o <<= 1) q += __shfl_xor(q, o);
    const float rstd = 1.f / sqrtf(q * (1.f / D) + LN_EPS);
#pragma unroll
    for (int j = 0; j < 4; ++j) { const f32x4 gg = ((const f32x4*)g)[lane + 64 * j], bb = ((const f32x4*)bta)[lane + 64 * j]; ((f32x4*)y)[lane + 64 * j] = v[j] * rstd * gg + bb; }
}
template <int NT, class Epi>
__device__ __forceinline__ void small_gemm(const bf16_t* A, const bf16_t* Bt, int N, int K, const Epi& epi, int w0, int nw, int lane) {
    const int ntiles = 8 * (N / (16 * NT)), r16 = lane & 15, kq = lane >> 4;
    for (int t = w0; t < ntiles; t += nw) {
        const int rt = t & 7, ct = t >> 3;
        const bf16_t* ap = A + (size_t)(rt * 16 + r16) * K + kq * 8;
        const bf16_t* bp = Bt + (size_t)(ct * 16 * NT + r16) * K + kq * 8;
        f32x4 acc[NT];
#pragma unroll
        for (int j = 0; j < NT; ++j) acc[j] = (f32x4){0.f, 0.f, 0.f, 0.f};
#pragma unroll 4
        for (int k = 0; k < K; k += 32) {
            const bf16x8 av = *(const bf16x8*)(ap + k);
#pragma unroll
            for (int j = 0; j < NT; ++j) { const bf16x8 bv = *(const bf16x8*)(bp + (size_t)j * 16 * K + k); acc[j] = __builtin_amdgcn_mfma_f32_16x16x32_bf16(av, bv, acc[j], 0, 0, 0); }
        }
#pragma unroll
        for (int j = 0; j < NT; ++j)
#pragma unroll
            for (int i = 0; i < 4; ++i) epi(rt * 16 + 4 * kq + i, ct * 16 * NT + j * 16 + r16, acc[j][i]);
    }
}


typedef float f32x16 __attribute__((ext_vector_type(16)));
typedef unsigned u32x2 __attribute__((ext_vector_type(2)));
__device__ __forceinline__ float ex2(float x) { return __builtin_amdgcn_exp2f(x); }
__device__ __forceinline__ float wave_sum64(float v) {
#pragma unroll
    for (int o = 1; o < 64; o <<= 1) v += __shfl_xor(v, o);
    return v;
}
__device__ __forceinline__ float wave_max64(float v) {
#pragma unroll
    for (int o = 1; o < 64; o <<= 1) v = fmaxf(v, __shfl_xor(v, o));
    return v;
}
constexpr int ATT_KSTR = 144, ATT_VSTR = 520, ATT_V_OFF = 256 * ATT_KSTR, ATT_B_OFF = ATT_V_OFF + 64 * ATT_VSTR;
constexpr int SMP_OFF = 81920, SMP_PER_WAVE = 4096;
__device__ __forceinline__ void attn_wave(const P& p, LAS unsigned char* L, int b, int kvh, int n, int hp, int wave, int lane) {
    const int hl = 2 * hp + (wave >> 2), head = 4 * kvh + hl, qs = wave & 3, q = lane & 31, h = lane >> 5;
    const unsigned rowq = (unsigned)b * SEQ + n * 128 + 32 * qs;
    bf16x8 qf[4];
#pragma unroll
    for (int s = 0; s < 4; ++s) qf[s] = *(const bf16x8*)(p.rp.Q + (rowq + q) * D + head * HD + 16 * s + 8 * h);
    f32x16 sc[5];
#pragma unroll
    for (int kt = 0; kt < 5; ++kt) {
        f32x16 acc = {};
#pragma unroll
        for (int s = 0; s < 4; ++s) { const bf16x8 kf = *(const LAS bf16x8*)(L + (32 * (qs + kt) + q) * ATT_KSTR + (16 * s + 8 * h) * 2); acc = __builtin_amdgcn_mfma_f32_32x32x16_bf16(kf, qf[s], acc, 0, 0, 0); }
        sc[kt] = acc; __builtin_amdgcn_sched_barrier(0);
    }
    const LAS float* BL = (const LAS float*)(L + ATT_B_OFF) + hl * 132;
    const float sink = ((const LAS float*)(L + ATT_B_OFF))[528 + hl];
    float m = sink;
#pragma unroll
    for (int kt = 0; kt < 5; ++kt)
#pragma unroll
        for (int r = 0; r < 16; ++r) {
            const int kk = (r & 3) + 8 * (r >> 2) + 4 * h, dist = 128 + q - 32 * kt - kk;
            const bool valid = (dist >= 0) && (dist <= 128) && (n > 0 || (qs + kt) >= 4);
            const int dc = dist < 0 ? 0 : (dist > 128 ? 128 : dist);
            const float v = valid ? sc[kt][r] + BL[dc] : -1e30f;
            sc[kt][r] = v; m = fmaxf(m, v);
            if (r == 15) __builtin_amdgcn_sched_barrier(0);
        }
    m = fmaxf(m, __shfl_xor(m, 32));
    float l = 0.f;
#pragma unroll
    for (int kt = 0; kt < 5; ++kt)
#pragma unroll
        for (int r = 0; r < 16; ++r) { const float e = ex2(sc[kt][r] - m); sc[kt][r] = e; l += e; }
    l += __shfl_xor(l, 32);
    l += ex2(sink - m);
    const float inv = 1.f / l;
    f32x16 o[2] = {};
#pragma unroll
    for (int kt = 0; kt < 5; ++kt)
#pragma unroll
        for (int s2 = 0; s2 < 2; ++s2) {
            v4u pw;
            pw.x = pk_bf16(sc[kt][8 * s2 + 0] * inv, sc[kt][8 * s2 + 1] * inv); pw.y = pk_bf16(sc[kt][8 * s2 + 2] * inv, sc[kt][8 * s2 + 3] * inv);
            pw.z = pk_bf16(sc[kt][8 * s2 + 4] * inv, sc[kt][8 * s2 + 5] * inv); pw.w = pk_bf16(sc[kt][8 * s2 + 6] * inv, sc[kt][8 * s2 + 7] * inv);
            const bf16x8 pa = __builtin_bit_cast(bf16x8, pw);
#pragma unroll
            for (int dh = 0; dh < 2; ++dh) {
                const LAS unsigned char* vb = L + ATT_V_OFF + (32 * dh + q) * ATT_VSTR + 2 * (32 * (qs + kt) + 16 * s2 + 4 * h);
                const u32x2 lo = *(const LAS u32x2*)vb, hi2 = *(const LAS u32x2*)(vb + 16);
                v4u vw; vw.x = lo.x; vw.y = lo.y; vw.z = hi2.x; vw.w = hi2.y;
                o[dh] = __builtin_amdgcn_mfma_f32_32x32x16_bf16(pa, __builtin_bit_cast(bf16x8, vw), o[dh], 0, 0, 0);
            }
            __builtin_amdgcn_sched_barrier(0);
        }
#pragma unroll
    for (int dh = 0; dh < 2; ++dh)
#pragma unroll
        for (int r = 0; r < 16; ++r) { const int i = (r & 3) + 8 * (r >> 2) + 4 * h; const unsigned idx = (rowq + i) * D + head * HD + 32 * dh + q;
            p.rp.Q[idx] = f2bf(o[dh][r] * bf2f(p.rp.SZA[idx])); }
}
__device__ __forceinline__ void attn_pair(const P& p, LAS unsigned char* L, int pair, int tid, int wave, int lane) {
    asm volatile("" : "+v"(tid), "+v"(lane));
    const int n = pair & 63, kvh = (pair >> 6) & 3, b = pair >> 8, pos0 = (n - 1) * 128;
    __syncthreads();
#pragma unroll
    for (int i = 0; i < 4; ++i) { const int idx = tid + 512 * i, key = idx >> 3, ch = idx & 7, pos = pos0 + key; v4u v = {0u, 0u, 0u, 0u};
        if (pos >= 0) v = *(const v4u*)(p.K + (unsigned)((b * SEQ + pos) * KVW + kvh * HD + ch * 8));
        *(LAS v4u*)(L + key * ATT_KSTR + ch * 16) = v; }
#pragma unroll
    for (int i = 0; i < 4; ++i) { const int idx = tid + 512 * i, d = idx >> 5, ch = idx & 31, pos = pos0 + ch * 8; v4u v = {0u, 0u, 0u, 0u};
        if (pos >= 0) v = *(const v4u*)(p.VT + (unsigned)(((b * NKV + kvh) * HD + d) * SEQ + pos));
        LAS unsigned char* dst = L + ATT_V_OFF + d * ATT_VSTR + ch * 16; u32x2 a, c2; a.x = v.x; a.y = v.y; c2.x = v.z; c2.y = v.w;
        *(LAS u32x2*)dst = a; *(LAS u32x2*)(dst + 8) = c2; }
    LAS float* BL = (LAS float*)(L + ATT_B_OFF);
    for (int idx = tid; idx < 4 * 132; idx += 512) BL[idx] = p.biasl[(4 * kvh) * 132 + idx];
    if (tid < 4) BL[528 + tid] = p.biasl[NH * 132 + 4 * kvh + tid];
    __syncthreads();
    attn_wave(p, L, b, kvh, n, 0, wave, lane);
    attn_wave(p, L, b, kvh, n, 1, wave, lane);
}
__device__ __forceinline__ void sattn_task(const P& p, LAS unsigned char* Sw, int task, int lane) {
    const int b = task >> 2, kvh = task & 3;
    LAS float* qsm = (LAS float*)Sw; LAS float* ps = qsm + 256;
#pragma unroll
    for (int i = 0; i < 4; ++i) qsm[i * 64 + lane] = bf2f(p.rs.Q[(size_t)b * D + (4 * kvh + i) * HD + lane]);
    LDS_WAIT(); asm volatile("" ::: "memory");
    const float* kc = p.in[6] + (size_t)b * WIN * KVW + kvh * HD; const float* vc = p.in[7] + (size_t)b * WIN * KVW + kvh * HD;
    const float* knew = p.out + OS_K + ((size_t)b * WIN + 127) * KVW + kvh * HD; const float* vnew = p.out + OS_V + ((size_t)b * WIN + 127) * KVW + kvh * HD;
    float sA[4] = {0.f, 0.f, 0.f, 0.f}, sB[4] = {0.f, 0.f, 0.f, 0.f}, sN[4];
#pragma unroll 4
    for (int d4 = 0; d4 < 16; ++d4) {
        const f32x4 ka = *(const f32x4*)(kc + (size_t)lane * KVW + 4 * d4), kb = *(const f32x4*)(kc + (size_t)(lane + 64) * KVW + 4 * d4);
#pragma unroll
        for (int hh = 0; hh < 4; ++hh) { const f32x4 qv = *(const LAS f32x4*)(qsm + hh * 64 + 4 * d4);
            sA[hh] += ka[0] * qv[0] + ka[1] * qv[1] + ka[2] * qv[2] + ka[3] * qv[3]; sB[hh] += kb[0] * qv[0] + kb[1] * qv[1] + kb[2] * qv[2] + kb[3] * qv[3]; }
    }
    { const float kn = knew[lane];
#pragma unroll
      for (int hh = 0; hh < 4; ++hh) sN[hh] = wave_sum64(qsm[hh * 64 + lane] * kn); }
#pragma unroll
    for (int hh = 0; hh < 4; ++hh) {
        const int head = 4 * kvh + hh; const float* bl = p.biasl + head * 132; const float sink = p.biasl[NH * 132 + head];
        const float a = sA[hh] + bl[128 - lane], bb = sB[hh] + bl[64 - lane], nn = sN[hh] + bl[0];
        float m = wave_max64(fmaxf(a, bb)); m = fmaxf(m, fmaxf(nn, sink));
        const float pa = ex2(a - m), pb = ex2(bb - m), pn = ex2(nn - m);
        const float l = wave_sum64(pa + pb) + pn + ex2(sink - m), inv = 1.f / l;
        ps[hh * 132 + lane] = pa * inv; ps[hh * 132 + 64 + lane] = pb * inv; if (lane == 0) ps[hh * 132 + 128] = pn * inv;
    }
    LDS_WAIT(); asm volatile("" ::: "memory");
    float o[4] = {0.f, 0.f, 0.f, 0.f};
#pragma unroll 8
    for (int j = 0; j < 128; ++j) { const float v = vc[(size_t)j * KVW + lane];
#pragma unroll
        for (int hh = 0; hh < 4; ++hh) o[hh] += ps[hh * 132 + j] * v; }
    { const float vn = vnew[lane];
#pragma unroll
      for (int hh = 0; hh < 4; ++hh) { o[hh] += ps[hh * 132 + 128] * vn; const size_t idx = (size_t)b * D + (4 * kvh + hh) * HD + lane; p.rs.Q[idx] = f2bf(o[hh] * bf2f(p.rs.SZA[idx])); } }
    LDS_WAIT(); asm volatile("" ::: "memory");
}
__device__ __forceinline__ void sssm_task(const P& p, LAS unsigned char* Sw, int task, int lane) {
    const int b = task >> 6, g = task & 63;
    LAS float* hs = (LAS float*)Sw;
    const bf16_t* up = p.rs.US + (size_t)b * D + g * GC;
    const float* br = p.bbf + ((size_t)(g * 2 + 0) * NP + lane) * GC; const float* bi = p.bbf + ((size_t)(g * 2 + 1) * NP + lane) * GC;
    float xr = 0.f, xi = 0.f;
#pragma unroll
    for (int c = 0; c < GC; ++c) { const float u = bf2f(up[c]); xr += br[c] * u; xi += bi[c] * u; }
    const int gp = g * NP + lane; const size_t si = ((size_t)b * NG + g) * NP + lane;
    const float ar = p.ar[gp], ai = p.ai[gp], h0r = p.in[4][si], h0i = p.in[5][si];
    const float hr = ar * h0r - ai * h0i + xr, hi = ar * h0i + ai * h0r + xi;
    p.out[OS_HR + si] = hr; p.out[OS_HI + si] = hi;
    hs[2 * lane] = hr; hs[2 * lane + 1] = hi;
    LDS_WAIT(); asm volatile("" ::: "memory");
    const int c = lane & 15, pq = lane >> 4;
    const float* cr = p.in[16] + ((size_t)g * GC + c) * NP + 16 * pq; const float* ci = p.in[17] + ((size_t)g * GC + c) * NP + 16 * pq;
    float acc = 0.f;
#pragma unroll
    for (int k = 0; k < 16; ++k) acc += cr[k] * hs[2 * (16 * pq + k)] - ci[k] * hs[2 * (16 * pq + k) + 1];
    acc += __shfl_xor(acc, 16); acc += __shfl_xor(acc, 32);
    if (pq == 0) { const float y = acc + p.in[18][g * GC + c] * bf2f(up[c]); p.rs.YG[(size_t)b * D + g * GC + c] = f2bf(gelu_tanh(y)); }
    LDS_WAIT(); asm volatile("" ::: "memory");
}
constexpr int SSM_HSTR = 272, SSM_PER_WAVE = 32 * SSM_HSTR;
template <bool PASS3>
__device__ __forceinline__ void ssm_task(const P& p, LAS unsigned char* Hw, int task, int lane) {
    const int j = task >> 6, g = task & 63, q = lane & 31, h = lane >> 5;
    const bf16_t* bbg = p.bb + (size_t)g * 2 * NP * GC;
    const bf16x8 Bre0 = *(const bf16x8*)(bbg + (size_t)(0 * NP + q) * GC + 8 * h), Bre1 = *(const bf16x8*)(bbg + (size_t)(0 * NP + 32 + q) * GC + 8 * h);
    const bf16x8 Bim0 = *(const bf16x8*)(bbg + (size_t)(1 * NP + q) * GC + 8 * h), Bim1 = *(const bf16x8*)(bbg + (size_t)(1 * NP + 32 + q) * GC + 8 * h);
    const float ar0 = p.ar[g * NP + q], ai0 = p.ai[g * NP + q], ar1 = p.ar[g * NP + 32 + q], ai1 = p.ai[g * NP + 32 + q];
    float h0r = 0.f, h0i = 0.f, h1r = 0.f, h1i = 0.f;
    typedef float f32x2 __attribute__((ext_vector_type(2)));
    if (PASS3) {
        const float tr0 = p.atr[g * NP + q], ti0 = p.ati[g * NP + q], tr1 = p.atr[g * NP + 32 + q], ti1 = p.ati[g * NP + 32 + q];
        const f32x2* e0 = (const f32x2*)p.E + ((size_t)(h * 64) * NG + g) * NP + q;
#pragma unroll 4
        for (int i = 0; i < j; ++i) { const f32x2 a = e0[(size_t)i * NG * NP], c = e0[(size_t)i * NG * NP + 32];
            const float n0r = tr0 * h0r - ti0 * h0i + a.x, n0i = tr0 * h0i + ti0 * h0r + a.y, n1r = tr1 * h1r - ti1 * h1i + c.x, n1i = tr1 * h1i + ti1 * h1r + c.y;
            h0r = n0r; h0i = n0i; h1r = n1r; h1i = n1i; }
    }
    bf16x8 Cf[4]; float dsk = 0.f;
    const int c16 = lane & 15, kq = lane >> 4;
    if (PASS3) {
#pragma unroll
        for (int s = 0; s < 4; ++s) Cf[s] = *(const bf16x8*)(p.cmt + ((size_t)g * GC + c16) * 128 + 32 * s + 8 * kq);
        dsk = p.in[18][g * GC + c16];
    }
    const int ab = (q >> 2) & 1, atl = (q & 3) + 4 * (q >> 3);
    const bf16_t* up = p.rp.US + ((size_t)ab * SEQ + j * 128 + atl) * D + g * GC + 8 * h;
    for (int st = 0; st < 8; ++st) {
        const bf16x8 a = *(const bf16x8*)(up + (size_t)st * 16 * D);
        const f32x16 z = {};
        f32x16 xr0 = __builtin_amdgcn_mfma_f32_32x32x16_bf16(a, Bre0, z, 0, 0, 0), xi0 = __builtin_amdgcn_mfma_f32_32x32x16_bf16(a, Bim0, z, 0, 0, 0);
        f32x16 xr1 = __builtin_amdgcn_mfma_f32_32x32x16_bf16(a, Bre1, z, 0, 0, 0), xi1 = __builtin_amdgcn_mfma_f32_32x32x16_bf16(a, Bim1, z, 0, 0, 0);
#pragma unroll
        for (int r = 0; r < 16; ++r) {
            const float n0r = ar0 * h0r - ai0 * h0i + xr0[r], n0i = ar0 * h0i + ai0 * h0r + xi0[r];
            const float n1r = ar1 * h1r - ai1 * h1i + xr1[r], n1i = ar1 * h1i + ai1 * h1r + xi1[r];
            h0r = n0r; h0i = n0i; h1r = n1r; h1i = n1i;
            if (PASS3) { LAS unsigned* hw = (LAS unsigned*)(Hw + (16 * h + r) * SSM_HSTR + 4 * q); hw[0] = pk_bf16(n0r, n0i); hw[32] = pk_bf16(n1r, n1i); }
        }
        if (PASS3) {
            LDS_WAIT(); asm volatile("" ::: "memory");
            f32x4 y0 = {0.f, 0.f, 0.f, 0.f}, y1 = {0.f, 0.f, 0.f, 0.f};
#pragma unroll
            for (int s = 0; s < 4; ++s) {
                const bf16x8 a0 = *(const LAS bf16x8*)(Hw + c16 * SSM_HSTR + (32 * s + 8 * kq) * 2), a1 = *(const LAS bf16x8*)(Hw + (16 + c16) * SSM_HSTR + (32 * s + 8 * kq) * 2);
                y0 = __builtin_amdgcn_mfma_f32_16x16x32_bf16(a0, Cf[s], y0, 0, 0, 0); y1 = __builtin_amdgcn_mfma_f32_16x16x32_bf16(a1, Cf[s], y1, 0, 0, 0);
            }
#pragma unroll
            for (int i = 0; i < 4; ++i) {
                const size_t r0 = ((size_t)j * 128 + st * 16 + 4 * kq + i) * D + g * GC + c16, r1 = r0 + (size_t)SEQ * D;
                p.rp.YG[r0] = f2bf(gelu_tanh(y0[i] + dsk * bf2f(p.rp.US[r0]))); p.rp.YG[r1] = f2bf(gelu_tanh(y1[i] + dsk * bf2f(p.rp.US[r1])));
            }
            LDS_WAIT(); asm volatile("" ::: "memory");
        }
    }
    if (!PASS3) { f32x2* e = (f32x2*)p.E + (((size_t)h * 64 + j) * NG + g) * NP + q; e[0] = (f32x2){h0r, h0i}; e[32] = (f32x2){h1r, h1i}; }
    else if (j == 63) { const size_t si = ((size_t)h * NG + g) * NP + q; p.out[OP_HR + si] = h0r; p.out[OP_HI + si] = h0i; p.out[OP_HR + si + 32] = h1r; p.out[OP_HI + si + 32] = h1i; }
}

constexpr int RING_OFF = 0, RING_BYTES = 131072;
constexpr int LDSCTL_OFF = RING_BYTES, MISC_OFF = LDSCTL_OFF + 320;
constexpr int LDS_BYTES = 147456;
constexpr int CW_BAR = 4096;
constexpr size_t CTL_ZERO_BYTES = 256 * 1024;

struct Args { P p; int ph_lo, ph_hi, li, pad; };

__global__ void __launch_bounds__(NWAVES * 64, 2) mega(Args a) {
    extern __shared__ __attribute__((aligned(16))) unsigned char lds[];
    const P& p = a.p;
    LAS unsigned char* L = (LAS unsigned char*)lds;
    volatile LAS unsigned* MISC = (volatile LAS unsigned*)(L + MISC_OFF);
    const int tid = threadIdx.x, lane = tid & 63, wave = __builtin_amdgcn_readfirstlane(tid >> 6);
    for (int u = tid; u < (LDS_BYTES - LDSCTL_OFF) / 4; u += NWAVES * 64) ((LAS unsigned*)(L + LDSCTL_OFF))[u] = 0u;
    __syncthreads();
    XcdBarrier bar = xcd_barrier_post((unsigned*)(p.ws + WS_CTL) + CW_BAR + a.li * XCD_BAR_WORDS, MISC + 8);
    const int lo = a.ph_lo, hi = a.ph_hi, G = gridDim.x;
    const int gw = (int)blockIdx.x * NWAVES + wave, NGW = G * NWAVES;
#define IN(k) (lo <= (k) && (k) < hi)
#define BOTH(k) (IN(k) && IN((k) + 1))

    if (IN(0)) {
        for (int t = blockIdx.x; t < 256; t += G) { if (t < 240) phase_mod(p, L, t); else phase_tables(p, (t - 240) * 512 + tid); }
        if (BOTH(0)) xcd_barrier(bar);
    }
    if (IN(1)) {
        phase_bulk(p, L, gw, NGW, wave, lane);
        if (BOTH(1)) xcd_barrier(bar);
    }
    if (IN(2)) {
        __syncthreads();
        pg8::Gemm g{p.rp.H, p.win, MP, DIN, D}; pg8::StaticOrder S; S.init(MP, DIN, G, (int)blockIdx.x);
        pg8::EpiInprojFast E{p.rp.US, p.rp.SZS, p.rp.Q, p.rp.SZA, p.rp.SGS, p.rp.SGA, p.K, p.VT, p.out};
        pg8::gemm_phase<pg8::EpiInprojFast, pg8::StaticOrder, true, true>(L + RING_OFF, g, S, E);
        if (G == 256) { if ((int)blockIdx.x >= 128) small_gemm<4>(p.rs.H, p.win, DIN, D, EpiInproj{p, 1, 0}, ((int)blockIdx.x - 128) * NWAVES + wave, 128 * NWAVES, lane); }
        else small_gemm<4>(p.rs.H, p.win, DIN, D, EpiInproj{p, 1, 0}, gw, NGW, lane);
        if (BOTH(2)) xcd_barrier(bar);
    }
    if (IN(3)) {
        for (int pr = blockIdx.x; pr < 512; pr += G) attn_pair(p, L, pr, tid, wave, lane);
        for (int t = gw; t < 64 * NG; t += NGW) ssm_task<false>(p, nullptr, t, lane);
        LAS unsigned char* Sw = L + SMP_OFF + wave * SMP_PER_WAVE;
        for (int t = gw; t < MS * NG; t += NGW) sssm_task(p, Sw, t, lane);
        for (int t = gw; t < 4 * MS * NKV; t += NGW) if ((t & 3) == 0) sattn_task(p, Sw, t >> 2, lane);
        if (BOTH(3)) xcd_barrier(bar);
    }
    if (IN(4)) {
        __syncthreads();
        for (int t = gw; t < 64 * NG; t += NGW) ssm_task<true>(p, L + wave * SSM_PER_WAVE, t, lane);
        small_gemm<1>(p.rs.YG, p.wglu, D, D, EpiGlu{p.in[20], p.rs}, gw, NGW, lane);
        small_gemm<1>(p.rs.Q, p.wba, D, D, EpiBa{p.rs}, (gw + NGW / 2) % NGW, NGW, lane);
        if (BOTH(4)) xcd_barrier(bar);
    }
    if (IN(5)) {
        __syncthreads();
        { pg8::Gemm g{p.rp.YG, p.wglu, MP, D, D}; pg8::StaticOrder S; S.init(MP, D, G, (int)blockIdx.x);
          pg8::EpiGluFast E{p.rp.YG, p.rp.SZS, p.rp.V, p.in[20]};
          pg8::gemm_phase<pg8::EpiGluFast, pg8::StaticOrder, true, true>(L + RING_OFF, g, S, E); }
        { pg8::Gemm g{p.rp.Q, p.wba, MP, D, D}; pg8::StaticOrder S; S.init(MP, D, G, (int)blockIdx.x);
          pg8::EpiGateFast<false> E{p.rp.SGA, nullptr, p.rp.T1};
          pg8::gemm_phase<pg8::EpiGateFast<false>, pg8::StaticOrder, true, true>(L + RING_OFF, g, S, E); }
        small_gemm<1>(p.rs.V, p.wbs, D, D, EpiBs{p.rs}, gw, NGW, lane);
        if (BOTH(5)) xcd_barrier(bar);
    }
    if (IN(6)) {
        __syncthreads();
        pg8::Gemm g{p.rp.V, p.wbs, MP, D, D}; pg8::StaticOrder S; S.init(MP, D, G, (int)blockIdx.x);
        pg8::EpiGateFast<true> E{p.rp.SGS, p.rp.T1, p.rp.MM};
        pg8::gemm_phase<pg8::EpiGateFast<true>, pg8::StaticOrder, true, true>(L + RING_OFF, g, S, E);
        small_gemm<1>(p.rs.MM, p.wout, D, D, EpiOut{p.mod, p.rs}, gw, NGW, lane);
        if (BOTH(6)) xcd_barrier(bar);
    }
    if (IN(7)) {
        __syncthreads();
        pg8::Gemm g{p.rp.MM, p.wout, MP, D, D}; pg8::StaticOrder S; S.init(MP, D, G, (int)blockIdx.x);
        pg8::EpiOutFast E{p.rp.x, p.mod, p.rp.y};
        pg8::gemm_phase<pg8::EpiOutFast, pg8::StaticOrder, true, true>(L + RING_OFF, g, S, E);
        if (BOTH(7)) xcd_barrier(bar);
    }
    if (IN(8)) {
        for (int m = gw; m < MP + MS; m += NGW) ln_row(m < MP ? p.rp.y + (size_t)m * D : p.rs.y + (size_t)(m - MP) * D, p.in[26], p.in[27], lane);
    }
#undef IN
#undef BOTH
}

__global__ void k_mod(P p) {
    const int idx = blockIdx.x * blockDim.x + threadIdx.x;
    if (idx >= 130 * 3072) return;
    const int r = idx / 3072, n = idx % 3072;
    const float* c = r < 2 ? p.in[2] + (size_t)r * D : p.in[3] + (size_t)(r - 2) * D;
    const float* w = p.in[8];
    float acc = p.in[9][n];
    for (int k = 0; k < D; ++k) acc += siluf_(c[k]) * w[(size_t)k * 3072 + n];
    p.mod[idx] = acc;
}
__global__ void k_tables(P p) {
    const int idx = blockIdx.x * blockDim.x + threadIdx.x;
    if (idx < NG * NP) {
        const int g = idx / NP;
        const double lr = p.in[11][idx], li = p.in[12][idx], dt = exp((double)p.in[13][g]);
        const double mag = exp(lr * dt), ar = mag * cos(li * dt), ai = mag * sin(li * dt);
        const double den = lr * lr + li * li, nr = ar - 1.0, cr = (nr * lr + ai * li) / den, ci = (ai * lr - nr * li) / den;
        p.ar[idx] = (float)ar; p.ai[idx] = (float)ai;
        double pr = ar, pi = ai;
        for (int s = 0; s < 7; ++s) { const double nr2 = pr * pr - pi * pi, ni2 = 2.0 * pr * pi; pr = nr2; pi = ni2; }
        p.atr[idx] = (float)pr; p.ati[idx] = (float)pi;
        const int pp = idx % NP;
        for (int c = 0; c < GC; ++c) {
            const double br = p.in[14][(size_t)idx * GC + c], bi = p.in[15][(size_t)idx * GC + c];
            const float bbr = (float)(cr * br - ci * bi), bbi = (float)(cr * bi + ci * br);
            p.bbf[((size_t)(g * 2 + 0) * NP + pp) * GC + c] = bbr; p.bbf[((size_t)(g * 2 + 1) * NP + pp) * GC + c] = bbi;
            p.bb[((size_t)(g * 2 + 0) * NP + pp) * GC + c] = f2bf(bbr); p.bb[((size_t)(g * 2 + 1) * NP + pp) * GC + c] = f2bf(bbi);
            p.cmt[((size_t)g * GC + c) * 128 + 2 * pp + 0] = f2bf(p.in[16][((size_t)g * GC + c) * NP + pp]);
            p.cmt[((size_t)g * GC + c) * 128 + 2 * pp + 1] = f2bf(-p.in[17][((size_t)g * GC + c) * NP + pp]);
        }
    }
    if (idx < NH * 132) {
        const int h = idx / 132, d = idx % 132;
        float v = 0.f;
        if (d <= 128) {
            int bucket;
            if (d < 16) bucket = d;
            else { const float df = (float)d; int large = 16 + (int)(logf(df / 16.f) / logf(8.f) * 16.f); bucket = large < 31 ? large : 31; }
            v = p.in[22][bucket * NH + h] * LOG2E;
        }
        p.biasl[idx] = v;
    }
    if (idx < NH) p.biasl[NH * 132 + idx] = p.in[21][idx] * LOG2E;
}
__global__ void k_transpose(const float* W, bf16_t* WT, int K, int N) {
    const size_t idx = (size_t)blockIdx.x * blockDim.x + threadIdx.x;
    if (idx >= (size_t)K * N) return;
    const int n = (int)(idx / K), k = (int)(idx % K);
    WT[idx] = f2bf(W[(size_t)k * N + n]);
}
__global__ void k_h(P p, Rows r) {
    const size_t idx = (size_t)blockIdx.x * blockDim.x + threadIdx.x;
    if (idx >= (size_t)r.M * D) return;
    const int row = (int)(idx / D), k = (int)(idx % D);
    const float* m = p.mod + (size_t)modrow(r, row) * 3072;
    r.H[idx] = f2bf(r.x[idx] * (1.f + m[1024 + k]) + m[k]);
}
__global__ void __launch_bounds__(64) k_ssm_naive(P p, Rows r, int T, int pad) {
    const int lane = threadIdx.x, g = blockIdx.x % NG, b = blockIdx.x / NG;
    const int gp = g * NP + lane;
    const float ar = p.ar[gp], ai = p.ai[gp];
    float bbr[GC], bbi[GC], cre[GC], cim[GC];
#pragma unroll
    for (int c = 0; c < GC; ++c) {
        bbr[c] = p.bbf[((size_t)(g * 2 + 0) * NP + lane) * GC + c]; bbi[c] = p.bbf[((size_t)(g * 2 + 1) * NP + lane) * GC + c];
        cre[c] = p.in[16][((size_t)g * GC + c) * NP + lane]; cim[c] = p.in[17][((size_t)g * GC + c) * NP + lane];
    }
    float hr = 0.f, hi = 0.f;
    if (r.is_sample) { hr = p.in[4][((size_t)b * NG + g) * NP + lane]; hi = p.in[5][((size_t)b * NG + g) * NP + lane]; }
    const float dsk = p.in[18][g * GC + (lane & 15)];
    for (int t = 0; t < T; ++t) {
        const size_t row = (size_t)b * T + t;
        const bf16_t* u = r.US + row * D + g * GC;
        float xr = 0.f, xi = 0.f, uu[GC];
#pragma unroll
        for (int c = 0; c < GC; ++c) { uu[c] = bf2f(u[c]); xr += bbr[c] * uu[c]; xi += bbi[c] * uu[c]; }
        const float nhr = ar * hr - ai * hi + xr, nhi = ar * hi + ai * hr + xi; hr = nhr; hi = nhi;
        float mine = 0.f, myu = 0.f;
#pragma unroll
        for (int c = 0; c < GC; ++c) {
            float v = cre[c] * hr - cim[c] * hi;
#pragma unroll
            for (int o = 1; o < 64; o <<= 1) v += __shfl_xor(v, o);
            if ((lane & 15) == c) { mine = v; myu = uu[c]; }
        }
        if (lane < GC) r.YG[row * D + g * GC + lane] = f2bf(gelu_tanh(mine + dsk * myu));
    }
    float* ohr = p.out + (r.is_sample ? OS_HR : OP_HR); float* ohi = p.out + (r.is_sample ? OS_HI : OP_HI);
    ohr[((size_t)b * NG + g) * NP + lane] = hr; ohi[((size_t)b * NG + g) * NP + lane] = hi;
}
__global__ void __launch_bounds__(64) k_attn_naive(P p) {
    const int idx = blockIdx.x * blockDim.x + threadIdx.x;
    if (idx >= NH * MP) return;
    const int head = idx / MP, row = idx % MP, b = row / SEQ, t = row % SEQ, kvh = head >> 2;
    const Rows& R = p.rp;
    float q[HD], o[HD];
#pragma unroll
    for (int d = 0; d < HD; ++d) { q[d] = bf2f(R.Q[(size_t)row * D + head * HD + d]); o[d] = 0.f; }
    const float sink = p.biasl[NH * 132 + head];
    float m = sink, l = 1.f;
    const int k0 = t - WIN < 0 ? 0 : t - WIN;
    for (int kp = k0; kp <= t; ++kp) {
        const bf16_t* kr = p.K + (size_t)(b * SEQ + kp) * KVW + kvh * HD;
        float s = 0.f;
#pragma unroll
        for (int d = 0; d < HD; ++d) s += q[d] * bf2f(kr[d]);
        s += p.biasl[head * 132 + (t - kp)];
        const float mn = fmaxf(m, s), f = exp2f(m - mn), pe = exp2f(s - mn);
        l = l * f + pe; m = mn;
        const bf16_t* vt = p.VT + ((size_t)(b * NKV + kvh) * HD) * SEQ + kp;
#pragma unroll
        for (int d = 0; d < HD; ++d) o[d] = o[d] * f + pe * bf2f(vt[(size_t)d * SEQ]);
    }
    const float inv = 1.f / l;
#pragma unroll
    for (int d = 0; d < HD; ++d) { const size_t i = (size_t)row * D + head * HD + d; R.Q[i] = f2bf(o[d] * inv * bf2f(R.SZA[i])); }
}
__global__ void k_cache_shift(P p) {
    const size_t idx = (size_t)blockIdx.x * blockDim.x + threadIdx.x;
    if (idx >= (size_t)MS * 127 * KVW) return;
    const int b = (int)(idx / (127 * KVW)), rem = (int)(idx % (127 * KVW));
    p.out[OS_K + (size_t)b * WIN * KVW + rem] = p.in[6][(size_t)b * WIN * KVW + KVW + rem];
    p.out[OS_V + (size_t)b * WIN * KVW + rem] = p.in[7][(size_t)b * WIN * KVW + KVW + rem];
}
__global__ void __launch_bounds__(64) k_attn_sample_naive(P p) {
    const int idx = blockIdx.x * blockDim.x + threadIdx.x;
    if (idx >= MS * NH) return;
    const int b = idx / NH, head = idx % NH, kvh = head >> 2;
    const Rows& R = p.rs;
    float q[HD], o[HD];
#pragma unroll
    for (int d = 0; d < HD; ++d) { q[d] = bf2f(R.Q[(size_t)b * D + head * HD + d]); o[d] = 0.f; }
    const float sink = p.biasl[NH * 132 + head];
    float m = sink, l = 1.f;
    for (int j = 0; j <= WIN; ++j) {
        const float* kr = j < WIN ? p.in[6] + ((size_t)b * WIN + j) * KVW + kvh * HD : p.out + OS_K + ((size_t)b * WIN + 127) * KVW + kvh * HD;
        const float* vr = j < WIN ? p.in[7] + ((size_t)b * WIN + j) * KVW + kvh * HD : p.out + OS_V + ((size_t)b * WIN + 127) * KVW + kvh * HD;
        float s = 0.f;
#pragma unroll
        for (int d = 0; d < HD; ++d) s += q[d] * kr[d];
        s += p.biasl[head * 132 + (WIN - j)];
        const float mn = fmaxf(m, s), f = exp2f(m - mn), pe = exp2f(s - mn);
        l = l * f + pe; m = mn;
#pragma unroll
        for (int d = 0; d < HD; ++d) o[d] = o[d] * f + pe * vr[d];
    }
    const float inv = 1.f / l;
#pragma unroll
    for (int d = 0; d < HD; ++d) { const size_t i = (size_t)b * D + head * HD + d; R.Q[i] = f2bf(o[d] * inv * bf2f(R.SZA[i])); }
}
__global__ void k_ln(P p, Rows r) {
    const int lane = threadIdx.x & 63, row = blockIdx.x * (blockDim.x / 64) + (threadIdx.x >> 6);
    if (row >= r.M) return;
    float* y = r.y + (size_t)row * D;
    float v[16], s = 0.f;
#pragma unroll
    for (int j = 0; j < 16; ++j) { v[j] = y[lane + 64 * j]; s += v[j]; }
#pragma unroll
    for (int o = 1; o < 64; o <<= 1) s += __shfl_xor(s, o);
    const float mean = s * (1.f / D); float q = 0.f;
#pragma unroll
    for (int j = 0; j < 16; ++j) { v[j] -= mean; q += v[j] * v[j]; }
#pragma unroll
    for (int o = 1; o < 64; o <<= 1) q += __shfl_xor(q, o);
    const float rstd = 1.f / sqrtf(q * (1.f / D) + LN_EPS);
#pragma unroll
    for (int j = 0; j < 16; ++j) { const int c = lane + 64 * j; y[c] = v[j] * rstd * p.in[26][c] + p.in[27][c]; }
}

static void fill_params(P& p, void* const* d_in, void* d_out, void* d_ws) {
    for (int i = 0; i < 28; ++i) p.in[i] = (const float*)d_in[i];
    p.out = (float*)d_out; p.ws = (unsigned char*)d_ws;
    unsigned char* ws = p.ws;
    p.mod = (float*)(ws + WS_MOD);
    p.ar = (float*)(ws + WS_AR); p.ai = p.ar + 4096; p.atr = p.ar + 8192; p.ati = p.ar + 12288;
    p.bbf = (float*)(ws + WS_BBF); p.bb = (bf16_t*)(ws + WS_BB); p.cmt = (bf16_t*)(ws + WS_CMT); p.biasl = (float*)(ws + WS_BIAS);
    p.win = (bf16_t*)(ws + WS_WIN); p.wglu = (bf16_t*)(ws + WS_WGLU); p.wbs = (bf16_t*)(ws + WS_WBS); p.wba = (bf16_t*)(ws + WS_WBA); p.wout = (bf16_t*)(ws + WS_WOUT);
    p.E = (float*)(ws + WS_E); p.K = (bf16_t*)(ws + WS_K); p.VT = (bf16_t*)(ws + WS_VT);
    Rows& a = p.rp; a.M = MP; a.is_sample = 0; a.x = p.in[0];
    a.H = (bf16_t*)d_out;
    a.YG = (bf16_t*)d_out;
    a.US = (bf16_t*)(ws + WS_US); a.SZS = (bf16_t*)(ws + WS_SZS); a.Q = (bf16_t*)(ws + WS_Q); a.SZA = (bf16_t*)(ws + WS_SZA);
    a.SGS = (bf16_t*)(ws + WS_SGS); a.SGA = (bf16_t*)(ws + WS_SGA);
    a.V = a.US; a.T1 = a.SZA; a.MM = a.SZS; a.y = p.out + OY_P;
    Rows& s = p.rs; s.M = MS; s.is_sample = 1; s.x = p.in[1];
    bf16_t* sb = (bf16_t*)(ws + WS_SAMPLE); const size_t SB = (size_t)MS * D;
    s.H = sb; s.US = sb + SB; s.SZS = sb + 2 * SB; s.Q = sb + 3 * SB; s.SZA = sb + 4 * SB; s.SGS = sb + 5 * SB; s.SGA = sb + 6 * SB;
    s.YG = sb + 7 * SB; s.V = sb + 8 * SB; s.T1 = sb + 9 * SB; s.MM = sb + 10 * SB; s.y = p.out + OY_S;
}
template <class Epi>
static void gemm_naive(hipStream_t st, const bf16_t* A, const bf16_t* Bt, int M, int N, int K, Epi e) {
    const size_t tot = (size_t)M * N;
    hipLaunchKernelGGL(k_gemm_naive<Epi>, dim3((unsigned)((tot + 255) / 256)), dim3(256), 0, st, A, Bt, M, N, K, 0, e);
}
static int g_grid = 0;
static void launch_mega(hipStream_t stream, const P& p, int lo, int hi, int li) {
    Args a{}; a.p = p; a.ph_lo = lo; a.ph_hi = hi; a.li = li; a.pad = 0;
    hipLaunchKernelGGL(mega, dim3(g_grid), dim3(NWAVES * 64), LDS_BYTES, stream, a);
    const hipError_t le = hipPeekAtLastError();
    if (le != hipSuccess) fprintf(stderr, "kernel_launch: mega launch [%d,%d) failed: %s\n", lo, hi, hipGetErrorName(le));
}
extern "C" void kernel_launch(void* const* d_in, const int* in_sizes, int n_in, void* d_out, int out_size, void* d_ws, size_t ws_size, hipStream_t stream) {
    if (n_in != 28 || (size_t)out_size != OUT_TOTAL || ws_size < WS_END) { fprintf(stderr, "kernel_launch: unexpected shapes n_in %d out %d ws %zu\n", n_in, out_size, ws_size); return; }
    if (g_grid == 0) {
        int dev = 0, cus = 0, per_cu = 0;
        if (hipGetDevice(&dev) != hipSuccess || hipDeviceGetAttribute(&cus, hipDeviceAttributeMultiprocessorCount, dev) != hipSuccess) { fprintf(stderr, "kernel_launch: device query failed\n"); g_grid = -1; return; }
        if (hipFuncSetAttribute((const void*)mega, hipFuncAttributeMaxDynamicSharedMemorySize, LDS_BYTES) != hipSuccess) { fprintf(stderr, "kernel_launch: hipFuncSetAttribute failed\n"); g_grid = -1; return; }
        if (hipOccupancyMaxActiveBlocksPerMultiprocessor(&per_cu, (const void*)mega, NWAVES * 64, LDS_BYTES) != hipSuccess || per_cu < 1) { fprintf(stderr, "kernel_launch: occupancy query says %d blocks/CU\n", per_cu); per_cu = 1; }
        (void)hipGetLastError();
        g_grid = cus;
        if (g_grid != 256) fprintf(stderr, "kernel_launch: note: %d CUs (built for 256)\n", g_grid);
    }
    if (g_grid < 0) return;
    P p{}; fill_params(p, d_in, d_out, d_ws);
    hipMemsetAsync((char*)d_ws + WS_CTL, 0, CTL_ZERO_BYTES, stream);
    const Rows drp = p.rp, drs = p.rs;
    launch_mega(stream, p, 0, 9, 0);
}
```
